# Optimizing an MI355X kernel written in HIP

```python
import math
import jax, jax.numpy as jnp
from jax import lax
import numpy as np

D_MODEL = 2048
BATCH = 8
SEQ = 4096
DEPTH = 4

HEAD_DIM = 64
EPS = 1e-6
A_HEADS = 4
A_DK = 128
A_DV = 128
A_CHUNK = 64
A_OUT = A_HEADS * A_DV
B_HEADS = 8
B_WIDTH = B_HEADS * HEAD_DIM
SB_BLOCK = 128
C_PATTERNS = ((128, 1), (512, 4), (2048, 16))
C_GROUPS = 3
C_HPG = 4
C_HEADS = C_GROUPS * C_HPG
C_WIDTH = C_HEADS * HEAD_DIM
C_OUT = C_HPG * HEAD_DIM
C_BLOCK = 128
D_HEADS = 8
D_KV_HEADS = 2
D_GROUP = D_HEADS // D_KV_HEADS
D_WINDOW = 128
D_BLOCK = 128
D_Q = D_HEADS * HEAD_DIM
D_KV = D_KV_HEADS * HEAD_DIM
REL_BUCKETS = 32
REL_MAX_DIST = 2048
REL_HEADS = C_HEADS + D_HEADS
D_FF = 5632
MIX_SIZES = (A_HEADS * A_DK, A_HEADS * A_DK, A_OUT, A_OUT,
             B_WIDTH, B_WIDTH, B_WIDTH,
             C_WIDTH, C_WIDTH, C_WIDTH,
             D_Q, D_KV, D_KV)
MIX_IN = sum(MIX_SIZES)
N_BRANCH = 4
IN_TOTAL = MIX_IN + N_BRANCH * D_MODEL
BRANCH_WIDTHS = (A_OUT, B_WIDTH, C_OUT, D_Q)
BR_TOTAL = sum(BRANCH_WIDTHS)

kernel_name = 'hybrid_gated_parallel_mixers_trunk'


def _rms_norm(x, g):
    xf = x.astype(jnp.float32)
    y = xf * lax.rsqrt(jnp.mean(xf * xf, axis=-1, keepdims=True) + EPS)
    return (y * g.astype(jnp.float32)).astype(x.dtype)


def _swiglu(x, w13, w2):
    gate, up = jnp.split(x @ w13, 2, axis=-1)
    return (jax.nn.silu(gate) * up) @ w2


def _rel_bucket(dist):
    max_exact = REL_BUCKETS // 2
    d = jnp.maximum(dist, 1).astype(jnp.float32)
    large = max_exact + (jnp.log(d / max_exact) / math.log(REL_MAX_DIST / max_exact)
                         * (REL_BUCKETS - max_exact)).astype(jnp.int32)
    large = jnp.minimum(large, REL_BUCKETS - 1)
    return jnp.where(dist < max_exact, dist, large)


def _with_prev_block(t, nb_axis):
    pad = [(0, 0)] * t.ndim
    pad[nb_axis] = (1, 0)
    prev = lax.slice_in_dim(jnp.pad(t, pad), 0, t.shape[nb_axis], axis=nb_axis)
    return jnp.concatenate([prev, t], axis=nb_axis + 1)


def _hgrn2(q, f_logit, i, g, lb, norm_g):
    Bn, T, _ = q.shape
    nc = T // A_CHUNK
    f32 = jnp.float32
    f = lb + (1.0 - lb) * jax.nn.sigmoid(f_logit.astype(f32))

    def chunks(t):
        return t.astype(f32).reshape(Bn, nc, A_CHUNK, A_HEADS, -1).transpose(1, 0, 3, 2, 4)

    qc, kc, vc, gc = chunks(q), chunks(1.0 - f), chunks(i), chunks(jnp.log(f))
    causal = jnp.tril(jnp.ones((A_CHUNK, A_CHUNK), dtype=bool))[:, :, None]

    def step(S, inp):
        qb, kb, vb, gb = inp
        b = jnp.cumsum(gb, axis=2)
        b_last = b[:, :, -1:, :]
        o_inter = jnp.einsum('bhtk,bhkv->bhtv', qb * jnp.exp(b), S)
        decay = jnp.exp(jnp.where(causal, b[:, :, :, None, :] - b[:, :, None, :, :], -jnp.inf))
        scores = jnp.einsum('bhtk,bhsk,bhtsk->bhts', qb, kb, decay)
        o = o_inter + jnp.einsum('bhts,bhsv->bhtv', scores, vb)
        S = (jnp.exp(b_last[:, :, 0, :, None]) * S
             + jnp.einsum('bhsk,bhsv->bhkv', kb * jnp.exp(b_last - b), vb))
        return S, o

    S0 = jnp.zeros((Bn, A_HEADS, A_DK, A_DV), f32)
    _, o = lax.scan(step, S0, (qc, kc, vc, gc))
    o = o.transpose(1, 0, 3, 2, 4).reshape(Bn, T, A_HEADS, A_DV)
    o = _rms_norm(o, norm_g) * jax.nn.silu(g.astype(f32).reshape(Bn, T, A_HEADS, A_DV))
    return o.reshape(Bn, T, A_OUT).astype(q.dtype)


def _stick_breaking(q, k, v):
    Bn, T, _ = q.shape
    nb = T // SB_BLOCK
    scale = HEAD_DIM ** -0.5
    qh = q.reshape(Bn, nb, SB_BLOCK, B_HEADS, HEAD_DIM).transpose(1, 0, 3, 2, 4)
    kh = k.reshape(Bn, T, B_HEADS, HEAD_DIM)
    vh = v.reshape(Bn, T, B_HEADS, HEAD_DIM)
    key_pos = jnp.arange(T)

    def block(args):
        qb, blk = args
        z = jnp.einsum('bhqd,bshd->bhqs', qb, kh).astype(jnp.float32) * scale
        q_pos = blk * SB_BLOCK + jnp.arange(SB_BLOCK)
        past = key_pos[None, :] < q_pos[:, None]
        log_keep = jnp.where(past, -jax.nn.softplus(z), 0.0)
        between = lax.cumsum(log_keep, axis=3, reverse=True) - log_keep
        a = jnp.where(past, jnp.exp(jax.nn.log_sigmoid(z) + between), 0.0)
        return jnp.einsum('bhqs,bshd->bqhd', a.astype(v.dtype), vh)

    o = lax.map(block, (qh, jnp.arange(nb)))
    return o.transpose(1, 0, 2, 3, 4).reshape(Bn, T, B_WIDTH)


def _dilated_group(q, k, v, bias_tab, window, dilation):
    Bn, T, H, d = q.shape
    span = C_BLOCK * dilation
    Tp = -(-T // span) * span
    L = Tp // dilation
    nb = L // C_BLOCK

    def to_sub(t):
        t = jnp.pad(t, ((0, 0), (0, Tp - T), (0, 0), (0, 0)))
        t = t.reshape(Bn, L, dilation, H, d).transpose(0, 2, 1, 3, 4)
        return t.reshape(Bn, dilation, nb, C_BLOCK, H, d)

    def from_sub(t):
        rest = t.shape[4:]
        t = jnp.moveaxis(t.reshape((Bn, dilation, L) + rest), 1, 2)
        return t.reshape((Bn, Tp) + rest)[:, :T]

    qb = to_sub(q)
    kk = _with_prev_block(to_sub(k), 2)
    vv = _with_prev_block(to_sub(v), 2)
    qi = jnp.arange(C_BLOCK)[:, None] + C_BLOCK
    kj = jnp.arange(2 * C_BLOCK)[None, :]
    dist = qi - kj
    valid = (dist >= 0) & (dist <= window // dilation)
    valid = valid[None] & ((jnp.arange(nb)[:, None, None] > 0) | (kj[None] >= C_BLOCK))
    bias = bias_tab[_rel_bucket(jnp.maximum(dist, 0) * dilation)].transpose(2, 0, 1)
    logits = jnp.einsum('brnqhd,brnkhd->brnhqk', qb, kk).astype(jnp.float32) * HEAD_DIM ** -0.5
    logits = jnp.where(valid[None, None, :, None], logits + bias.astype(jnp.float32), -jnp.inf)
    m = jnp.max(logits, axis=-1, keepdims=True)
    p = jnp.exp(logits - m)
    den = jnp.sum(p, axis=-1)
    o = jnp.einsum('brnhqk,brnkhd->brnqhd', p, vv.astype(jnp.float32))
    o = o / jnp.swapaxes(den, -1, -2)[..., None]
    lse = jnp.swapaxes(m[..., 0] + jnp.log(den), -1, -2)
    return from_sub(o), from_sub(lse)


def _dilated_mixture(q, k, v, bias_tab):
    Bn, T, _ = q.shape
    q = q.reshape(Bn, T, C_GROUPS, C_HPG, HEAD_DIM)
    k = k.reshape(Bn, T, C_GROUPS, C_HPG, HEAD_DIM)
    v = v.reshape(Bn, T, C_GROUPS, C_HPG, HEAD_DIM)
    outs, lses = [], []
    for g, (window, dilation) in enumerate(C_PATTERNS):
        o, lse = _dilated_group(q[:, :, g], k[:, :, g], v[:, :, g],
                                bias_tab[:, g * C_HPG:(g + 1) * C_HPG], window, dilation)
        outs.append(o)
        lses.append(lse)
    w = jax.nn.softmax(jnp.stack(lses), axis=0)
    o = jnp.sum(w[..., None] * jnp.stack(outs), axis=0)
    return o.reshape(Bn, T, C_OUT).astype(q.dtype)


def _swa_sinks(q, k, v, sinks, bias_tab):
    Bn, T, _ = q.shape
    nb = T // D_BLOCK
    qb = q.reshape(Bn, nb, D_BLOCK, D_KV_HEADS, D_GROUP, HEAD_DIM)
    kk = _with_prev_block(k.reshape(Bn, nb, D_BLOCK, D_KV_HEADS, HEAD_DIM), 1)
    vv = _with_prev_block(v.reshape(Bn, nb, D_BLOCK, D_KV_HEADS, HEAD_DIM), 1)
    qi = jnp.arange(D_BLOCK)[:, None] + D_BLOCK
    kj = jnp.arange(2 * D_BLOCK)[None, :]
    dist = qi - kj
    valid = (dist >= 0) & (dist < D_WINDOW)
    valid = valid[None] & ((jnp.arange(nb)[:, None, None] > 0) | (kj[None] >= D_BLOCK))
    bias = bias_tab[_rel_bucket(jnp.maximum(dist, 0))].transpose(2, 0, 1)
    bias = bias.reshape(D_KV_HEADS, D_GROUP, D_BLOCK, 2 * D_BLOCK).astype(jnp.float32)
    logits = jnp.einsum('bnqkgd,bnskd->bnkgqs', qb, kk).astype(jnp.float32) * HEAD_DIM ** -0.5
    logits = jnp.where(valid[None, :, None, None], logits + bias, -jnp.inf)
    s = sinks.astype(jnp.float32).reshape(D_KV_HEADS, D_GROUP, 1, 1)
    m = jnp.maximum(jnp.max(logits, axis=-1, keepdims=True), s)
    p = jnp.exp(logits - m)
    den = jnp.sum(p, axis=-1, keepdims=True) + jnp.exp(s - m)
    o = jnp.einsum('bnkgqs,bnskd->bnqkgd', p / den, vv.astype(jnp.float32))
    return o.reshape(Bn, T, D_Q).astype(q.dtype)


def _token_mixing(u, w_in, lb, hgrn_norm_g, sinks, w_branch, w_out, rel_bias):
    proj = u @ w_in[:, :MIX_IN]
    (a_q, a_f, a_i, a_g, b_q, b_k, b_v, c_q, c_k, c_v, d_q, d_k, d_v) = jnp.split(
        proj, np.cumsum(MIX_SIZES)[:-1].tolist(), axis=-1)
    ys = (_hgrn2(a_q, a_f, a_i, a_g, lb, hgrn_norm_g),
          _stick_breaking(b_q, b_k, b_v),
          _dilated_mixture(c_q, c_k, c_v, rel_bias[:, :C_HEADS]),
          _swa_sinks(d_q, d_k, d_v, sinks, rel_bias[:, C_HEADS:]))
    merged = None
    row = 0
    for idx, (y, width) in enumerate(zip(ys, BRANCH_WIDTHS)):
        col = MIX_IN + idx * D_MODEL
        gate = jax.nn.sigmoid(u @ w_in[:, col:col + D_MODEL])
        term = gate * (y @ w_branch[row:row + width])
        merged = term if merged is None else merged + term
        row += width
    return merged @ w_out


def setup_inputs(seed: int = 0) -> dict:
    key = jax.random.key(seed)
    ks = jax.random.split(key, 16)
    D = D_MODEL

    def normal(k, shape, scale):
        return jax.random.normal(k, shape, jnp.float32) * scale

    br_scale = jnp.concatenate([jnp.full((w,), w ** -0.5, jnp.float32) for w in BRANCH_WIDTHS])
    return {
        'x': normal(ks[0], (BATCH, SEQ, D), 1.0),
        'ffn1_norm': 1.0 + normal(ks[1], (DEPTH, 2, D), 0.05),
        'ffn1_w13': normal(ks[2], (DEPTH, D, 2 * D_FF), D ** -0.5),
        'ffn1_w2': normal(ks[3], (DEPTH, D_FF, D), D_FF ** -0.5),
        'mix_norm': 1.0 + normal(ks[4], (DEPTH, 2, D), 0.05),
        'w_in': normal(ks[5], (DEPTH, D, IN_TOTAL), D ** -0.5),
        'hgrn_lb_logits': normal(ks[6], (DEPTH, A_HEADS * A_DK), 0.1),
        'hgrn_out_norm': 1.0 + normal(ks[7], (DEPTH, A_DV), 0.05),
        'attn_sinks': normal(ks[8], (DEPTH, D_HEADS), 0.5),
        'w_branch': normal(ks[9], (DEPTH, BR_TOTAL, D), 1.0) * br_scale[None, :, None],
        'w_out': normal(ks[10], (DEPTH, D, D), D ** -0.5),
        'ffn2_norm': 1.0 + normal(ks[11], (DEPTH, 2, D), 0.05),
        'ffn2_w13': normal(ks[12], (DEPTH, D, 2 * D_FF), D ** -0.5),
        'ffn2_w2': normal(ks[13], (DEPTH, D_FF, D), D_FF ** -0.5),
        'rel_bias': normal(ks[14], (REL_BUCKETS, REL_HEADS), 0.5),
    }


def reference(x, ffn1_norm, ffn1_w13, ffn1_w2, mix_norm, w_in, hgrn_lb_logits, hgrn_out_norm,
              attn_sinks, w_branch, w_out, ffn2_norm, ffn2_w13, ffn2_w2, rel_bias):
    lb_sm = jax.nn.softmax(hgrn_lb_logits.astype(jnp.float32), axis=0)
    lb_all = jnp.cumsum(lb_sm, axis=0) - lb_sm[0:1]
    h = x
    for l in range(DEPTH):
        f1 = _swiglu(_rms_norm(h, ffn1_norm[l, 0]), ffn1_w13[l], ffn1_w2[l])
        h = h + 0.5 * _rms_norm(f1, ffn1_norm[l, 1])
        u = _rms_norm(h, mix_norm[l, 0])
        mix = _token_mixing(u, w_in[l], lb_all[l], hgrn_out_norm[l], attn_sinks[l],
                            w_branch[l], w_out[l], rel_bias)
        h = h + _rms_norm(mix, mix_norm[l, 1])
        f2 = _swiglu(_rms_norm(h, ffn2_norm[l, 0]), ffn2_w13[l], ffn2_w2[l])
        h = h + 0.5 * _rms_norm(f2, ffn2_norm[l, 1])
    return h
```

```cpp
#include <hip/hip_runtime.h>
#include <cstdio>

#ifndef MK_ONE_LAUNCH
#define MK_ONE_LAUNCH 1
#endif
#ifndef COLCH
#define COLCH 2
#endif
#ifndef F8MASK
#define F8MASK 15
#endif
#ifndef GSP2
#define GSP2 true
#endif
#ifndef GALIGN
#define GALIGN true
#endif
#ifndef RPT_MASK
#define RPT_MASK 0
#endif
#ifndef PHMASK
#define PHMASK 0x3fff
#endif

#define LAS __attribute__((address_space(3)))
typedef unsigned short bf16_t;
typedef short bf16x8 __attribute__((ext_vector_type(8)));
typedef float f32x4 __attribute__((ext_vector_type(4)));
typedef unsigned u32x4 __attribute__((ext_vector_type(4)));
typedef unsigned u32x2 __attribute__((ext_vector_type(2)));

constexpr int DM = 2048, NBATCH = 8, SEQ = 4096, DEPTH = 4, M = NBATCH * SEQ;
constexpr int DFF = 5632, NIN = 14848, MIXIN = 6656, BRT = 1792, NGATE = 8192;
constexpr float EPS = 1e-6f;
constexpr int AQ = 0, AF = 512, AI = 1024, AG = 1536, BQ = 2048, BKo = 2560, BVo = 3072, CQ = 3584, CKo = 4352, CVo = 5120, DQo = 5888, DKo = 6400, DVo = 6528;
constexpr int NCHUNK = M / 64;

constexpr size_t MiB = 1u << 20;
constexpr size_t WS_CTL = 0;
constexpr size_t WS_W13A = 1 * MiB;
constexpr size_t WS_W2A = WS_W13A + 44 * MiB;
constexpr size_t WS_WIN = WS_W2A + 22 * MiB;
constexpr size_t WS_WBR = WS_WIN + 58 * MiB;
constexpr size_t WS_WOUT = WS_WBR + 7 * MiB;
constexpr size_t WS_W13B = WS_WOUT + 8 * MiB;
constexpr size_t WS_W2B = WS_W13B + 44 * MiB;
constexpr size_t WS_WG8 = WS_W2B + 22 * MiB;
constexpr size_t WS_XN = WS_WG8 + 16 * MiB;
constexpr size_t WS_H16 = WS_XN + 128 * MiB;
constexpr size_t WS_R = WS_H16 + 128 * MiB;
constexpr size_t WS_ACT = WS_R;
constexpr size_t WS_F_FFN = WS_R + 352 * MiB;
constexpr size_t WS_PROJ = WS_R;
constexpr size_t WS_GATES = WS_R + 416 * MiB;
constexpr size_t WS_YALL = WS_GATES + 512 * MiB;
constexpr size_t WS_QI = WS_YALL + 112 * MiB;
constexpr size_t WS_OINTRA = WS_QI + 32 * MiB;
constexpr size_t WS_SPREV = WS_OINTRA + 64 * MiB;
constexpr size_t WS_DC = WS_SPREV + 64 * MiB;
constexpr size_t WS_CPART = WS_DC + 1 * MiB;
constexpr size_t WS_CLSE = WS_CPART + 48 * MiB;
constexpr size_t WS_END = WS_CLSE + 2 * MiB;
constexpr size_t WS_U = WS_XN;
constexpr size_t WS_MERGED = WS_PROJ;
constexpr size_t WS_F_MIX = WS_GATES;
constexpr size_t WS_XN8 = WS_XN;
constexpr float GATE_WSCALE = 32.0f;
constexpr int CW_BAR = 4096;

typedef _Float16 h16x2 __attribute__((ext_vector_type(2)));
typedef _Float16 h16x8 __attribute__((ext_vector_type(8)));
__device__ __forceinline__ unsigned cvt_pk_bf16(float lo, float hi) { h16x2 v; v.x = (_Float16)lo; v.y = (_Float16)hi; return __builtin_bit_cast(unsigned, v); }
__device__ __forceinline__ bf16_t f2bf(float f) { return __builtin_bit_cast(unsigned short, (_Float16)f); }
__device__ __forceinline__ float bf2f(bf16_t b) { return (float)__builtin_bit_cast(_Float16, b); }
__device__ __forceinline__ float bflo(unsigned w) { return (float)__builtin_bit_cast(h16x2, w).x; }
__device__ __forceinline__ float bfhi(unsigned w) { return (float)__builtin_bit_cast(h16x2, w).y; }
#define MFMA16(a, b, c) __builtin_amdgcn_mfma_f32_16x16x32_f16(__builtin_bit_cast(h16x8, (a)), __builtin_bit_cast(h16x8, (b)), (c), 0, 0, 0)
__device__ __forceinline__ unsigned cvt_pk_b16(float lo, float hi) { unsigned r; asm volatile("v_cvt_pk_bf16_f32 %0, %1, %2" : "=v"(r) : "v"(lo), "v"(hi)); return r; }
__device__ __forceinline__ bf16_t f2b16(float f) { return (bf16_t)(cvt_pk_b16(f, 0.f) & 0xffffu); }
__device__ __forceinline__ float b16lo(unsigned w) { return __uint_as_float(w << 16); }
__device__ __forceinline__ float b16hi(unsigned w) { return __uint_as_float(w & 0xffff0000u); }
#define MFMAB(a, b, c) __builtin_amdgcn_mfma_f32_16x16x32_bf16((a), (b), (c), 0, 0, 0)
typedef int v8i32 __attribute__((ext_vector_type(8)));
typedef int v4i32 __attribute__((ext_vector_type(4)));
__device__ __forceinline__ unsigned pk_fp8x4(float a, float b, float c, float d) { int w = __builtin_amdgcn_cvt_pk_fp8_f32(a, b, 0, false); w = __builtin_amdgcn_cvt_pk_fp8_f32(c, d, w, true); return (unsigned)w; }
__device__ __forceinline__ f32x4 mfma_fp8(const bf16x8 a0, const bf16x8 a1, const bf16x8 b0, const bf16x8 b1, const f32x4 c) {
    const u32x4 x0 = __builtin_bit_cast(u32x4, a0), x1 = __builtin_bit_cast(u32x4, a1), y0 = __builtin_bit_cast(u32x4, b0), y1 = __builtin_bit_cast(u32x4, b1);
    const v8i32 A = {(int)x0.x, (int)x0.y, (int)x0.z, (int)x0.w, (int)x1.x, (int)x1.y, (int)x1.z, (int)x1.w}, B = {(int)y0.x, (int)y0.y, (int)y0.z, (int)y0.w, (int)y1.x, (int)y1.y, (int)y1.z, (int)y1.w};
    return __builtin_amdgcn_mfma_scale_f32_16x16x128_f8f6f4(A, B, c, 0, 0, 0, 0x7f7f7f7f, 0, 0x7f7f7f7f);
}
__device__ __forceinline__ float wave_sum(float v) {
#pragma unroll
    for (int o = 1; o < 64; o <<= 1) v += __shfl_xor(v, o);
    return v;
}
__device__ __forceinline__ float fast_sigmoid(float x) { return __builtin_amdgcn_rcpf(1.0f + __expf(-x)); }
#define LDS_WAIT() asm volatile("s_waitcnt lgkmcnt(0)" ::: "memory")
template <int CTRL> __device__ __forceinline__ float dpp_f(float x) { return __builtin_bit_cast(float, __builtin_amdgcn_update_dpp(0, __builtin_bit_cast(int, x), CTRL, 0xf, 0xf, true)); }
__device__ __forceinline__ float row16_max(float v) { v = fmaxf(v, dpp_f<0xB1>(v)); v = fmaxf(v, dpp_f<0x4E>(v)); v = fmaxf(v, dpp_f<0x141>(v)); v = fmaxf(v, dpp_f<0x140>(v)); return v; }
__device__ __forceinline__ float row16_sum(float v) { v += dpp_f<0xB1>(v); v += dpp_f<0x4E>(v); v += dpp_f<0x141>(v); v += dpp_f<0x140>(v); return v; }

template <int TOFF> __device__ __forceinline__ void tr_frag4(unsigned addr, bf16x8 (&v)[4]) {
    u32x2 a0, a1, b0, b1, c0, c1, d0, d1;
    asm volatile("ds_read_b64_tr_b16 %0, %8\n\tds_read_b64_tr_b16 %1, %8 offset:%9\n\tds_read_b64_tr_b16 %2, %8 offset:32\n\tds_read_b64_tr_b16 %3, %8 offset:%10\n\t"
                 "ds_read_b64_tr_b16 %4, %8 offset:64\n\tds_read_b64_tr_b16 %5, %8 offset:%11\n\tds_read_b64_tr_b16 %6, %8 offset:96\n\tds_read_b64_tr_b16 %7, %8 offset:%12\n\ts_waitcnt lgkmcnt(0)"
                 : "=&v"(a0), "=&v"(a1), "=&v"(b0), "=&v"(b1), "=&v"(c0), "=&v"(c1), "=&v"(d0), "=&v"(d1) : "v"(addr), "n"(TOFF), "n"(TOFF + 32), "n"(TOFF + 64), "n"(TOFF + 96) : "memory");
    v[0] = __builtin_bit_cast(bf16x8, (u32x4){a0.x, a0.y, a1.x, a1.y}); v[1] = __builtin_bit_cast(bf16x8, (u32x4){b0.x, b0.y, b1.x, b1.y});
    v[2] = __builtin_bit_cast(bf16x8, (u32x4){c0.x, c0.y, c1.x, c1.y}); v[3] = __builtin_bit_cast(bf16x8, (u32x4){d0.x, d0.y, d1.x, d1.y});
}
__device__ __forceinline__ unsigned lds_addr(const LAS void* p) { return (unsigned)(size_t)p; }

#define XB_TMO      128
#define XB_XCNT(j)  (256  + 64 * (j))
#define XB_XSUB(j)  (1280 + 64 * (j))
#define XB_XGEN(j)  (2304 + 64 * (j))
#define XB_TOP      3328
#define XB_TOPGEN   3392
#define XCD_BAR_WORDS 3456
#define XB_SPIN_CAP (1u << 18)

__device__ __forceinline__ unsigned xb_ld(unsigned* p)              { return __hip_atomic_load(p, __ATOMIC_RELAXED, __HIP_MEMORY_SCOPE_AGENT); }
__device__ __forceinline__ unsigned xb_add(unsigned* p, unsigned v) { return __hip_atomic_fetch_add(p, v, __ATOMIC_RELAXED, __HIP_MEMORY_SCOPE_AGENT); }
__device__ __forceinline__ unsigned xb_xcc_id() { return (unsigned)__builtin_amdgcn_s_getreg((3 << 11) | 20) & 0xFu; }
#define XB_SPIN(cond, bar) do { unsigned _sp = 0; while (cond) { __builtin_amdgcn_s_sleep(1); \
    if ((++_sp & 255u) == 0u) { if (xb_ld(&(bar)[XB_TMO])) break; if (_sp > XB_SPIN_CAP) { atomicAdd(&(bar)[XB_TMO], 1u); break; } } } } while (0)

struct XcdBarrier { unsigned* bar; unsigned x; volatile LAS unsigned* st; };

__device__ __forceinline__ XcdBarrier xcd_barrier_post(unsigned* bar, volatile LAS unsigned* st) {
    XcdBarrier b; b.bar = bar; b.x = xb_xcc_id(); b.st = st;
    if (threadIdx.x == 0) (void)xb_add(&bar[XB_XCNT(b.x)], 1u);
    return b;
}
__device__ __forceinline__ void xcd_barrier_complete(unsigned* bar, unsigned x, unsigned& nloc, unsigned& nx) {
    const unsigned G = gridDim.x * gridDim.y * gridDim.z;
    unsigned sum, cnt, mine, sp = 0u;
    for (;;) {
        sum = 0u; cnt = 0u; mine = 0u;
#pragma unroll
        for (unsigned j = 0; j < 16; ++j) { const unsigned c = xb_ld(&bar[XB_XCNT(j)]); sum += c; cnt += (c > 0u) ? 1u : 0u; mine = (j == x) ? c : mine; }
        if (sum == G) break;
        __builtin_amdgcn_s_sleep(1);
        if ((++sp & 255u) == 0u) { if (xb_ld(&bar[XB_TMO])) break; if (sp > XB_SPIN_CAP) { atomicAdd(&bar[XB_TMO], 1u); break; } }
    }
    nloc = mine > 0u ? mine : 1u; nx = cnt > 0u ? cnt : 1u;
}
__device__ __forceinline__ void xcd_barrier(const XcdBarrier& b) {
    asm volatile("s_waitcnt vmcnt(0)" ::: "memory");
    __syncthreads();
    if (threadIdx.x == 0) {
        unsigned* bar = b.bar;
        __builtin_amdgcn_s_waitcnt(0);
        unsigned nloc = b.st[0], nx = b.st[1];
        if (nloc == 0u) { xcd_barrier_complete(bar, b.x, nloc, nx); b.st[0] = nloc; b.st[1] = nx; }
        const unsigned old = xb_add(&bar[XB_XSUB(b.x)], 1u);
        const unsigned gen = old / nloc;
        if (old + 1u == (gen + 1u) * nloc) {
            __builtin_amdgcn_fence(__ATOMIC_RELEASE, "agent");
            asm volatile("s_waitcnt vmcnt(0)" ::: "memory");
            const unsigned og = xb_add(&bar[XB_TOP], 1u);
            const unsigned tg = og / nx;
            if (og + 1u == (tg + 1u) * nx) xb_add(&bar[XB_TOPGEN], 1u);
            else XB_SPIN(xb_ld(&bar[XB_TOPGEN]) == tg, bar);
            __builtin_amdgcn_fence(__ATOMIC_ACQUIRE, "agent");
            xb_add(&bar[XB_XGEN(b.x)], 1u);
            asm volatile("s_waitcnt vmcnt(0)" ::: "memory");
        } else {
            XB_SPIN(xb_ld(&bar[XB_XGEN(b.x)]) == gen, bar);
            __builtin_amdgcn_fence(__ATOMIC_ACQUIRE, "agent");
            asm volatile("s_waitcnt vmcnt(0)" ::: "memory");
        }
    }
    __syncthreads();
}

namespace pg8 {
constexpr int BM = 256, BK = 64, HALF = 128, HTB = HALF * BK * 2, STAGE_BYTES = 8 * HTB, NXCD = 8, WGM = 4;
__device__ __forceinline__ int lds_byte(int r, int c) { const int st = (r >> 4) * 2 + (c >> 5), rr = r & 15, cc = c & 31, ob = rr * 64 + cc * 2; return st * 1024 + (ob ^ (((ob >> 9) & 1) << 5)); }
__device__ __forceinline__ void stage_rc(int b, int& R, int& C) { const int st = b / 1024, sb = b % 1024, swz = sb ^ (((sb >> 9) & 1) << 5); R = (st >> 1) * 16 + swz / 64; C = (st & 1) * 32 + (swz % 64) / 2; }
__device__ __forceinline__ int perm32(int rho) { const int n = rho >> 4, i = rho & 15; return 8 * (i >> 2) + 4 * n + (i & 3); }

struct Unit { int pm, pn, aux, nt; const char* A; const char* B; };

struct TileOrder {
    int nM, nN, nwg, G, c, rev;
    __device__ __forceinline__ void init(int nM_, int nN_, int G_, int c_, int rev_ = 0) { nM = nM_; nN = nN_; nwg = nM * nN; G = G_; c = c_; rev = rev_; }
    __device__ __forceinline__ bool tile(int i, int& pm, int& pn) const {
        const long L = (long)i * G + c; if (L >= nwg) return false;
        int wgid = (int)L; { const int q = nwg / NXCD, r = nwg % NXCD, xcd = wgid % NXCD; int off = wgid / NXCD; if ((rev & 1) && r == 0) off = q - 1 - off;
            wgid = (xcd < r ? xcd * (q + 1) : r * (q + 1) + (xcd - r) * q) + off; }
        if (rev & 2) {
            const int nig = WGM * nM, gid = wgid / nig, fn = gid * WGM, gsz = (nN - fn) < WGM ? (nN - fn) : WGM;
            pn = fn + ((wgid % nig) % gsz); pm = (wgid % nig) / gsz; return true; }
        const int nig = WGM * nN, gid = wgid / nig, fm = gid * WGM, gsz = (nM - fm) < WGM ? (nM - fm) : WGM;
        pm = fm + ((wgid % nig) % gsz); pn = (wgid % nig) / gsz; return true;
    }
};
struct SchedPlain {
    TileOrder o; const char* A; const char* B; size_t tstepA, tstepB; int nt; int bmap = -1;
    __device__ __forceinline__ bool next(int i, Unit& u) const {
        if (!o.tile(i, u.pm, u.pn)) return false;
        if (bmap >= 0) u.pn = 8 * ((bmap >> (4 * (u.pn >> 3))) & 15) + (u.pn & 7);
        u.A = A + (size_t)u.pm * tstepA; u.B = B + (size_t)u.pn * tstepB; u.nt = nt; u.aux = 0; return true;
    }
};
struct SchedBranch {
    TileOrder o; const char* A; const char* B; size_t tstepA, tstepB;
    __device__ __forceinline__ bool next(int i, Unit& u) const {
        if (!o.tile(i >> 2, u.pm, u.pn)) return false;
        const int br = i & 3; const int koff = br == 0 ? 0 : (br == 1 ? 512 : (br == 2 ? 1024 : 1280));
        u.A = A + (size_t)u.pm * tstepA + (size_t)koff * 2; u.B = B + (size_t)u.pn * tstepB + (size_t)koff * 2; u.nt = (br == 2) ? 4 : 8; u.aux = br; return true;
    }
};

struct EpiBf16 {
    bf16_t* O; int ldc;
    __device__ __forceinline__ bool operator()(f32x4 (&acc)[2][2][4][2], const Unit& u, int wr, int wc, int fr, int fq) const {
        const int row0 = u.pm * BM + wr * 64 + fr, col0 = u.pn * BM + wc * 32 + 8 * fq;
#pragma unroll
        for (int ai = 0; ai < 2; ++ai)
#pragma unroll
            for (int m = 0; m < 4; ++m) { bf16_t* rowp = O + (size_t)(row0 + ai * HALF + m * 16) * ldc + col0;
#pragma unroll
                for (int bj = 0; bj < 2; ++bj) { const f32x4 v0 = acc[ai][bj][m][0], v1 = acc[ai][bj][m][1];
                    u32x4 w; w.x = cvt_pk_bf16(v0[0], v0[1]); w.y = cvt_pk_bf16(v0[2], v0[3]); w.z = cvt_pk_bf16(v1[0], v1[1]); w.w = cvt_pk_bf16(v1[2], v1[3]);
                    *(u32x4*)(rowp + bj * HALF) = w; } }
        return true;
    }
};
struct EpiSwiglu {
    bf16_t* O; int ldc;
    __device__ __forceinline__ bool operator()(f32x4 (&acc)[2][2][4][2], const Unit& u, int wr, int wc, int fr, int fq) const {
        typedef float f32x2 __attribute__((ext_vector_type(2)));
        const int row0 = u.pm * BM + wr * 64 + fr, col0 = u.pn * HALF + wc * 32 + 8 * fq;
#pragma unroll
        for (int ai = 0; ai < 2; ++ai)
#pragma unroll
            for (int m = 0; m < 4; ++m) { bf16_t* rowp = O + (size_t)(row0 + ai * HALF + m * 16) * ldc + col0;
                unsigned w[4];
#pragma unroll
                for (int n = 0; n < 2; ++n)
#pragma unroll
                    for (int jp = 0; jp < 2; ++jp) { const f32x2 g = {acc[ai][0][m][n][2 * jp], acc[ai][0][m][n][2 * jp + 1]}, up = {acc[ai][1][m][n][2 * jp], acc[ai][1][m][n][2 * jp + 1]};
                        f32x2 e; e.x = __builtin_amdgcn_exp2f(g.x); e.y = __builtin_amdgcn_exp2f(g.y);
                        const f32x2 d = e + 1.0f; f32x2 r; r.x = __builtin_amdgcn_rcpf(d.x); r.y = __builtin_amdgcn_rcpf(d.y);
                        const f32x2 h = (g * up) * r; w[n * 2 + jp] = cvt_pk_b16(h.x, h.y); }
                *(u32x4*)rowp = (u32x4){w[0], w[1], w[2], w[3]}; }
        return true;
    }
};
struct EpiInproj {
    bf16_t* P; bf16_t* Gt;
    __device__ __forceinline__ bool operator()(f32x4 (&acc)[2][2][4][2], const Unit& u, int wr, int wc, int fr, int fq) const {
        const int row0 = u.pm * BM + wr * 64 + fr; const bool isg = u.pn >= 26;
        bf16_t* base = isg ? Gt : P; const int ldc = isg ? NGATE : MIXIN; const int col0 = (isg ? (u.pn - 26) : u.pn) * BM + wc * 32 + 8 * fq;
#pragma unroll
        for (int ai = 0; ai < 2; ++ai)
#pragma unroll
            for (int m = 0; m < 4; ++m) { bf16_t* rowp = base + (size_t)(row0 + ai * HALF + m * 16) * ldc + col0;
#pragma unroll
                for (int bj = 0; bj < 2; ++bj) { f32x4 v0 = acc[ai][bj][m][0], v1 = acc[ai][bj][m][1];
                    if (isg) {
#pragma unroll
                        for (int j = 0; j < 4; ++j) { v0[j] = fminf(1.0f + __expf(-v0[j]), 60000.0f); v1[j] = fminf(1.0f + __expf(-v1[j]), 60000.0f); } }
                    u32x4 w; w.x = cvt_pk_bf16(v0[0], v0[1]); w.y = cvt_pk_bf16(v0[2], v0[3]); w.z = cvt_pk_bf16(v1[0], v1[1]); w.w = cvt_pk_bf16(v1[2], v1[3]);
                    *(u32x4*)(rowp + bj * HALF) = w; } }
        return true;
    }
};
struct EpiGates {
    unsigned char* Gt; float inv;
    __device__ __forceinline__ bool operator()(f32x4 (&acc)[2][2][4][2], const Unit& u, int wr, int wc, int fr, int fq) const {
        const int row0 = u.pm * BM + wr * 64 + fr, col0 = u.pn * BM + wc * 32 + 8 * fq; const float ninv2 = -inv * 1.44269504089f;
#pragma unroll
        for (int ai = 0; ai < 2; ++ai)
#pragma unroll
            for (int m = 0; m < 4; ++m) { unsigned char* rowp = Gt + (size_t)(row0 + ai * HALF + m * 16) * NGATE + col0;
#pragma unroll
                for (int bj = 0; bj < 2; ++bj) { const f32x4 v0 = acc[ai][bj][m][0] * ninv2, v1 = acc[ai][bj][m][1] * ninv2;
                    f32x4 e0, e1;
#pragma unroll
                    for (int j = 0; j < 4; ++j) { e0[j] = fminf(__builtin_amdgcn_exp2f(v0[j]), 500.0f); e1[j] = fminf(__builtin_amdgcn_exp2f(v1[j]), 500.0f); }
                    e0 = e0 + 1.0f; e1 = e1 + 1.0f;
                    f32x4 g0, g1;
#pragma unroll
                    for (int j = 0; j < 4; ++j) { g0[j] = __builtin_amdgcn_rcpf(e0[j]); g1[j] = __builtin_amdgcn_rcpf(e1[j]); }
                    g0 = g0 * 255.0f; g1 = g1 * 255.0f;
                    unsigned w0 = 0u, w1 = 0u;
#pragma unroll
                    for (int j = 0; j < 4; ++j) { w0 = __builtin_amdgcn_cvt_pk_u8_f32(__builtin_rintf(g0[j]), j, w0); w1 = __builtin_amdgcn_cvt_pk_u8_f32(__builtin_rintf(g1[j]), j, w1); }
                    *(u32x2*)(rowp + bj * HALF) = (u32x2){w0, w1}; } }
        return true;
    }
};
struct EpiBranch {
    bf16_t* Mg; const unsigned char* Gt;
    __device__ __forceinline__ void apply(f32x4 (&acc)[2][2][4][2], int ai, int m, int bj, const u32x2 c8, const u32x2 n8, int br, size_t off) const {
        f32x4 v0 = acc[ai][bj][m][0], v1 = acc[ai][bj][m][1];
#define UB(w, k) ((float)(((w) >> (8 * (k))) & 0xffu))
        v0[0] *= UB(c8.x, 0) * __builtin_amdgcn_rcpf(UB(n8.x, 0)); v0[1] *= UB(c8.x, 1) * __builtin_amdgcn_rcpf(UB(n8.x, 1));
        v0[2] *= UB(c8.x, 2) * __builtin_amdgcn_rcpf(UB(n8.x, 2)); v0[3] *= UB(c8.x, 3) * __builtin_amdgcn_rcpf(UB(n8.x, 3));
        v1[0] *= UB(c8.y, 0) * __builtin_amdgcn_rcpf(UB(n8.y, 0)); v1[1] *= UB(c8.y, 1) * __builtin_amdgcn_rcpf(UB(n8.y, 1));
        v1[2] *= UB(c8.y, 2) * __builtin_amdgcn_rcpf(UB(n8.y, 2)); v1[3] *= UB(c8.y, 3) * __builtin_amdgcn_rcpf(UB(n8.y, 3));
#undef UB
        if (br < 3) { acc[ai][bj][m][0] = v0; acc[ai][bj][m][1] = v1; }
        else { u32x4 w; w.x = cvt_pk_b16(v0[0], v0[1]); w.y = cvt_pk_b16(v0[2], v0[3]); w.z = cvt_pk_b16(v1[0], v1[1]); w.w = cvt_pk_b16(v1[2], v1[3]); *(u32x4*)(Mg + off) = w; }
    }
    __device__ __forceinline__ bool operator()(f32x4 (&acc)[2][2][4][2], const Unit& u, int wr, int wc, int fr, int fq) const {
        const int row0 = u.pm * BM + wr * 64 + fr, col0 = u.pn * BM + wc * 32 + 8 * fq; const int br = u.aux;
        const u32x2 one = (u32x2){0xffffffffu, 0xffffffffu};
        u32x2 ec[3][2], en[3][2];
#define EB_LOAD(buf, q) do { _Pragma("unroll") for (int bj = 0; bj < 2; ++bj) { \
            const unsigned char* gp = Gt + (size_t)(row0 + ((q) >> 2) * HALF + ((q) & 3) * 16) * NGATE + (size_t)br * DM + col0 + bj * HALF; \
            ec[buf][bj] = *(const u32x2*)gp; en[buf][bj] = one; if (br < 3) en[buf][bj] = *(const u32x2*)(gp + DM); } } while (0)
#define EB_APPLY(buf, q) do { _Pragma("unroll") for (int bj = 0; bj < 2; ++bj) \
            apply(acc, (q) >> 2, (q) & 3, bj, ec[buf][bj], en[buf][bj], br, (size_t)(row0 + ((q) >> 2) * HALF + ((q) & 3) * 16) * DM + col0 + bj * HALF); } while (0)
        EB_LOAD(0, 0); asm volatile("" ::: "memory");
        EB_LOAD(1, 1); asm volatile("" ::: "memory");
        EB_LOAD(2, 2); asm volatile("" ::: "memory");
        EB_APPLY(0, 0); asm volatile("" ::: "memory"); EB_LOAD(0, 3); asm volatile("" ::: "memory");
        EB_APPLY(1, 1); asm volatile("" ::: "memory"); EB_LOAD(1, 4); asm volatile("" ::: "memory");
        EB_APPLY(2, 2); asm volatile("" ::: "memory"); EB_LOAD(2, 5); asm volatile("" ::: "memory");
        EB_APPLY(0, 3); asm volatile("" ::: "memory"); EB_LOAD(0, 6); asm volatile("" ::: "memory");
        EB_APPLY(1, 4); asm volatile("" ::: "memory"); EB_LOAD(1, 7); asm volatile("" ::: "memory");
        EB_APPLY(2, 5); asm volatile("" ::: "memory");
        EB_APPLY(0, 6); asm volatile("" ::: "memory");
        EB_APPLY(1, 7); asm volatile("" ::: "memory");
#undef EB_LOAD
#undef EB_APPLY
        return br == 3;
    }
};

template <bool F8 = false, bool SP2 = false, bool ALIGN = false, class Epi, class Sched>
__device__ __forceinline__ void gemm_phase(LAS unsigned char* lds, const int lda, const int ldb, const Sched& S, const Epi& E) {
    int tid_ = threadIdx.x; asm volatile("" : "+v"(tid_));
    const int tid = tid_, wid = __builtin_amdgcn_readfirstlane(tid >> 6), lane = tid & 63, wr = wid >> 2, wc = wid & 3, fr = lane & 15, fq = lane >> 4;
    unsigned voffA[2], voffB[2];
#pragma unroll
    for (int i = 0; i < 2; ++i) { int R, C; stage_rc(tid * 16 + i * 8192, R, C); const int Rb = (R & ~31) + perm32(R & 31);
        voffA[i] = (unsigned)(R * lda + C) * 2u; voffB[i] = (unsigned)(Rb * ldb + C) * 2u; }
    const size_t kstep = (size_t)(BK * 2);
    const size_t hstepA = (size_t)HALF * lda * 2, hstepB = (size_t)HALF * ldb * 2;
    const unsigned ldsw = (unsigned)wid * 1024u;
    const int aoff = lds_byte(wr * 64 + fr, fq * 8), boff = lds_byte(wc * 32 + fr, fq * 8);
#define PG8_SA(b, h) (((b) * 2 + (h)) * HTB)
#define PG8_SB(b, h) ((4 + (b) * 2 + (h)) * HTB)
#define PG8_STAGE(bufoff, gbase, voff) do { _Pragma("unroll") for (int _i = 0; _i < 2; ++_i) \
        __builtin_amdgcn_global_load_lds((const unsigned*)((const char*)(gbase) + (voff)[_i]), (LAS unsigned*)(lds + (bufoff) + ldsw + _i * 8192), 16, 0, 0); } while (0)
#define PG8_LDA(dst, b, h) do { if constexpr (F8) { _Pragma("unroll") for (int m = 0; m < 4; ++m) { A8[m].lo = *(const LAS v4i32*)(lds + PG8_SA(b, h) + aoff + m * 2048); A8[m].hi = *(const LAS v4i32*)(lds + PG8_SA(b, h) + aoff + m * 2048 + 1024); } } \
        else { _Pragma("unroll") for (int m = 0; m < 4; ++m) _Pragma("unroll") for (int k = 0; k < 2; ++k) dst[m][k] = *(const LAS bf16x8*)(lds + PG8_SA(b, h) + aoff + m * 2048 + k * 1024); } } while (0)
#define PG8_LDB(dst, b, h) do { if constexpr (F8) { _Pragma("unroll") for (int n = 0; n < 2; ++n) { dst##8[n].lo = *(const LAS v4i32*)(lds + PG8_SB(b, h) + boff + n * 2048); dst##8[n].hi = *(const LAS v4i32*)(lds + PG8_SB(b, h) + boff + n * 2048 + 1024); } } \
        else { _Pragma("unroll") for (int n = 0; n < 2; ++n) _Pragma("unroll") for (int k = 0; k < 2; ++k) dst[n][k] = *(const LAS bf16x8*)(lds + PG8_SB(b, h) + boff + n * 2048 + k * 1024); } } while (0)
#define PG8_MMA(ai, bj, At, Bt) do { __builtin_amdgcn_s_setprio(1); _Pragma("unroll") for (int m = 0; m < 4; ++m) _Pragma("unroll") for (int n = 0; n < 2; ++n) { \
        if constexpr (F8) asm volatile("v_mfma_scale_f32_16x16x128_f8f6f4 %0, %1, %2, %0, %3, %3 op_sel_hi:[0,0,0]" : "+v"(acc[ai][bj][m][n]) : "v"(Bt##8[n]), "v"(A8[m]), "v"(sc8)); \
        else { _Pragma("unroll") for (int k = 0; k < 2; ++k) acc[ai][bj][m][n] = MFMAB(Bt[n][k], At[m][k], acc[ai][bj][m][n]); } } __builtin_amdgcn_s_setprio(0); } while (0)
#define PG8_WAIT_V(n) asm volatile("s_waitcnt vmcnt(" #n ")" ::: "memory")
#define PG8_WAIT_L(n) asm volatile("s_waitcnt lgkmcnt(" #n ")" ::: "memory")
#define PG8_BAR __builtin_amdgcn_s_barrier()
#define PG8_SCHED __builtin_amdgcn_sched_barrier(0)
    Unit cur, nxt; int ui = 0;
    if (!S.next(0, cur)) return;
    f32x4 acc[2][2][4][2];
#pragma unroll
    for (int a = 0; a < 2; ++a)
#pragma unroll
        for (int b = 0; b < 2; ++b)
#pragma unroll
            for (int m = 0; m < 4; ++m)
#pragma unroll
                for (int n = 0; n < 2; ++n) acc[a][b][m][n] = (f32x4){0.f, 0.f, 0.f, 0.f};
    bf16x8 At[4][2], B0[2][2], B1[2][2];
    v8i32 A8[4], B08[2], B18[2];
    const int sc8 = 0x7f7f7f7f;
    const char* cA = cur.A; const char* cB = cur.B; int nt = cur.nt;
    if constexpr (SP2) {
        PG8_STAGE(PG8_SB(0, 0), cB, voffB); PG8_STAGE(PG8_SB(0, 1), cB + hstepB, voffB); PG8_STAGE(PG8_SA(0, 0), cA, voffA); PG8_STAGE(PG8_SA(0, 1), cA + hstepA, voffA);
        if (wr == 1) PG8_BAR;
        PG8_WAIT_V(2); PG8_BAR;
        PG8_STAGE(PG8_SB(1, 0), cB + kstep, voffB); PG8_STAGE(PG8_SA(1, 0), cA + kstep, voffA); PG8_STAGE(PG8_SB(1, 1), cB + hstepB + kstep, voffB);
        PG8_WAIT_V(6); PG8_BAR;
    } else {
    PG8_STAGE(PG8_SB(0, 0), cB, voffB); PG8_STAGE(PG8_SA(0, 0), cA, voffA); PG8_STAGE(PG8_SB(0, 1), cB + hstepB, voffB); PG8_STAGE(PG8_SA(0, 1), cA + hstepA, voffA);
    if (wr == 1) PG8_BAR;
    PG8_WAIT_V(4); PG8_BAR;
    PG8_STAGE(PG8_SB(1, 0), cB + kstep, voffB); PG8_STAGE(PG8_SA(1, 0), cA + kstep, voffA); PG8_STAGE(PG8_SB(1, 1), cB + hstepB + kstep, voffB);
    PG8_WAIT_V(6); PG8_BAR;
    }
    for (;;) {
        const bool has_next = S.next(ui + 1, nxt);
        const char* nA = has_next ? nxt.A : cA; const char* nB = has_next ? nxt.B : cB;
        for (int t = 0; t < nt; t += 2) {
            const bool last = (t == nt - 2);
            const char* a1 = cA + (size_t)(t + 1) * kstep;
            const char* a2 = last ? nA : cA + (size_t)(t + 2) * kstep; const char* b2 = last ? nB : cB + (size_t)(t + 2) * kstep;
            const char* a3 = a2 + kstep; const char* b3 = b2 + kstep;
            if constexpr (SP2) {
            PG8_LDB(B0, 0, 0); PG8_LDB(B1, 0, 1); PG8_SCHED; PG8_LDA(At, 0, 0); PG8_STAGE(PG8_SA(1, 1), a1 + hstepA, voffA);
            PG8_WAIT_V(8); PG8_WAIT_L(0); PG8_BAR; PG8_MMA(0, 0, At, B0); PG8_MMA(0, 1, At, B1); PG8_BAR; PG8_SCHED;
            PG8_LDA(At, 0, 1); PG8_STAGE(PG8_SB(0, 0), b2, voffB); PG8_STAGE(PG8_SB(0, 1), b2 + hstepB, voffB); PG8_STAGE(PG8_SA(0, 0), a2, voffA);
            PG8_WAIT_V(8); PG8_WAIT_L(0); PG8_BAR; PG8_MMA(1, 0, At, B0); PG8_MMA(1, 1, At, B1); PG8_BAR; PG8_SCHED;
            PG8_LDB(B0, 1, 0); PG8_LDB(B1, 1, 1); PG8_SCHED; PG8_LDA(At, 1, 0); PG8_STAGE(PG8_SA(0, 1), a2 + hstepA, voffA);
            PG8_WAIT_V(8); PG8_WAIT_L(0); PG8_BAR; PG8_MMA(0, 0, At, B0); PG8_MMA(0, 1, At, B1); PG8_BAR; PG8_SCHED;
            PG8_LDA(At, 1, 1); PG8_STAGE(PG8_SB(1, 0), b3, voffB); PG8_STAGE(PG8_SB(1, 1), b3 + hstepB, voffB); PG8_STAGE(PG8_SA(1, 0), a3, voffA);
            PG8_WAIT_V(8); PG8_WAIT_L(0); PG8_BAR; PG8_MMA(1, 0, At, B0); PG8_MMA(1, 1, At, B1); PG8_BAR; PG8_SCHED;
            } else {
            PG8_LDB(B0, 0, 0); PG8_SCHED; PG8_LDA(At, 0, 0); PG8_STAGE(PG8_SA(1, 1), a1 + hstepA, voffA);
            PG8_WAIT_L(8); PG8_BAR; PG8_WAIT_L(0); PG8_MMA(0, 0, At, B0); PG8_BAR; PG8_SCHED;
            PG8_LDB(B1, 0, 1); PG8_STAGE(PG8_SB(0, 0), b2, voffB);
            PG8_BAR; PG8_WAIT_L(0); PG8_MMA(0, 1, At, B1); PG8_BAR;
            PG8_LDA(At, 0, 1); PG8_STAGE(PG8_SA(0, 0), a2, voffA);
            PG8_BAR; PG8_WAIT_L(0); PG8_MMA(1, 0, At, B0); PG8_BAR; PG8_SCHED;
            PG8_STAGE(PG8_SB(0, 1), b2 + hstepB, voffB);
            PG8_WAIT_V(6); PG8_BAR; PG8_MMA(1, 1, At, B1); PG8_BAR;
            PG8_LDB(B0, 1, 0); PG8_SCHED; PG8_LDA(At, 1, 0); PG8_STAGE(PG8_SA(0, 1), a2 + hstepA, voffA);
            PG8_WAIT_L(8); PG8_BAR; PG8_WAIT_L(0); PG8_MMA(0, 0, At, B0); PG8_BAR; PG8_SCHED;
            PG8_LDB(B1, 1, 1); PG8_STAGE(PG8_SB(1, 0), b3, voffB);
            PG8_BAR; PG8_WAIT_L(0); PG8_MMA(0, 1, At, B1); PG8_BAR;
            PG8_LDA(At, 1, 1); PG8_STAGE(PG8_SA(1, 0), a3, voffA);
            PG8_BAR; PG8_WAIT_L(0); PG8_MMA(1, 0, At, B0); PG8_BAR; PG8_SCHED;
            PG8_STAGE(PG8_SB(1, 1), b3 + hstepB, voffB);
            PG8_WAIT_V(6); PG8_BAR; PG8_MMA(1, 1, At, B1); PG8_BAR;
            }
        }
        if constexpr (ALIGN) { if (wr == 0) PG8_BAR; }
        const bool consumed = E(acc, cur, wr, wc, fr, fq);
        if (!has_next) break;
        if (consumed)
#pragma unroll
        for (int a = 0; a < 2; ++a)
#pragma unroll
            for (int b = 0; b < 2; ++b)
#pragma unroll
                for (int m = 0; m < 4; ++m)
#pragma unroll
                    for (int n = 0; n < 2; ++n) acc[a][b][m][n] = (f32x4){0.f, 0.f, 0.f, 0.f};
        cur = nxt; cA = nA; cB = nB; nt = cur.nt; ++ui;
        if constexpr (ALIGN) { if (wr == 1) PG8_BAR; }
    }
    PG8_WAIT_V(0);
    if constexpr (!ALIGN) { if (wr == 0) PG8_BAR; }
    PG8_BAR;
#undef PG8_SA
#undef PG8_SB
#undef PG8_STAGE
#undef PG8_LDA
#undef PG8_LDB
#undef PG8_MMA
#undef PG8_WAIT_V
#undef PG8_WAIT_L
#undef PG8_BAR
#undef PG8_SCHED
}
}

constexpr int branch_list(int mask) { int r = 0, n = 0; for (int b = 0; b < 4; ++b) if ((mask >> b) & 1) { r |= b << (4 * n); ++n; } return r; }
struct Args {
    const float* x; const float* ffn1_norm; const float* ffn1_w13; const float* ffn1_w2; const float* mix_norm; const float* w_in; const float* lb_logits; const float* hgrn_norm;
    const float* sinks; const float* w_branch; const float* w_out; const float* ffn2_norm; const float* ffn2_w13; const float* ffn2_w2; const float* rel_bias;
    float* out; unsigned char* ws;
    int l_lo, l_hi, ph_lo, ph_hi;
};

struct ConvDesc { const float* W; const float* gk; bf16_t* WT; unsigned char* W8; int K, N, k0, n0, drow0; float wscale; };
__device__ __forceinline__ ConvDesc conv_desc(const Args& a, int l, int it) {
    unsigned char* ws = a.ws;
    constexpr int I13 = (DM / 128) * (2 * DFF / 64), I2 = (DFF / 128) * (DM / 64), IIN = (DM / 128) * (NIN / 64), IBR = (BRT / 128) * (DM / 64);
    ConvDesc d; d.gk = nullptr; d.W8 = nullptr; d.WT = nullptr; d.wscale = 1.0f;
    int r = it;
    if (r < 2 * I13) {
        const bool second = r >= I13; if (second) r -= I13;
        d.W = (second ? a.ffn2_w13 : a.ffn1_w13) + (size_t)l * DM * 2 * DFF; d.WT = (bf16_t*)(ws + (second ? WS_W13B : WS_W13A));
        const int nblk = 2 * DFF / 64, kb = r / nblk, nb = r % nblk, n0 = 64 * nb;
        const int isup = n0 >= DFF; const int j = isup ? n0 - DFF : n0;
        d.K = DM; d.N = 2 * DFF; d.k0 = 128 * kb; d.n0 = n0; d.drow0 = 256 * (j / 128) + (isup ? 128 : 0) + (j % 128);
        d.gk = (second ? a.ffn2_norm : a.ffn1_norm) + (size_t)(l * 2) * DM; d.wscale = __uint_as_float((unsigned)__builtin_amdgcn_readfirstlane((int)(isup ? 0xbf317218u : 0xbfb8aa3bu))); return d; }
    r -= 2 * I13;
    if (r < 2 * I2) {
        const bool second = r >= I2; if (second) r -= I2;
        d.W = (second ? a.ffn2_w2 : a.ffn1_w2) + (size_t)l * DFF * DM; d.WT = (bf16_t*)(ws + (second ? WS_W2B : WS_W2A));
        const int nblk = DM / 64, kb = r / nblk, nb = r % nblk;
        d.K = DFF; d.N = DM; d.k0 = 128 * kb; d.n0 = 64 * nb; d.drow0 = 64 * nb; return d; }
    r -= 2 * I2;
    if (r < IIN) { const int nblk = NIN / 64, kb = r / nblk, nb = r % nblk;
        d.W = a.w_in + (size_t)l * DM * NIN; d.K = DM; d.N = NIN; d.k0 = 128 * kb; d.n0 = 64 * nb; d.gk = a.mix_norm + (size_t)(l * 2) * DM;
        if (64 * nb >= MIXIN && ((F8MASK >> ((64 * nb - MIXIN) / DM)) & 1)) { d.W8 = ws + WS_WG8; d.drow0 = 64 * nb - MIXIN; d.wscale = GATE_WSCALE; }
        else { d.WT = (bf16_t*)(ws + WS_WIN); d.drow0 = 64 * nb; }
        return d; }
    r -= IIN;
    if (r < IBR) { const int nblk = DM / 64, kb = r / nblk, nb = r % nblk;
        d.W = a.w_branch + (size_t)l * BRT * DM; d.WT = (bf16_t*)(ws + WS_WBR); d.K = BRT; d.N = DM; d.k0 = 128 * kb; d.n0 = 64 * nb; d.drow0 = 64 * nb; return d; }
    r -= IBR;
    { const int nblk = DM / 64, kb = r / nblk, nb = r % nblk;
        d.W = a.w_out + (size_t)l * DM * DM; d.WT = (bf16_t*)(ws + WS_WOUT); d.K = DM; d.N = DM; d.k0 = 128 * kb; d.n0 = 64 * nb; d.drow0 = 64 * nb; return d; }
}
__device__ __forceinline__ void conv_load(const ConvDesc& d, float (&v)[16], int wave, int lane) {
#pragma unroll
    for (int i = 0; i < 16; ++i) { const int k = d.k0 + wave * 16 + i; v[i] = d.W[(size_t)k * d.N + d.n0 + lane] * ((d.gk ? d.gk[k] : 1.0f) * d.wscale); }
}
__device__ __forceinline__ void convert_weights(const Args& a, int l, LAS unsigned char* lds, int bid, int G, int lane, int wave) {
    LAS float* tile = (LAS float*)lds;
    constexpr int I13 = (DM / 128) * (2 * DFF / 64), I2 = (DFF / 128) * (DM / 64), IIN = (DM / 128) * (NIN / 64), IBR = (BRT / 128) * (DM / 64), IOUT = (DM / 128) * (DM / 64);
    constexpr int NITEMS = 2 * I13 + 2 * I2 + IIN + IBR + IOUT;
    asm volatile("" : "+s"(bid));
    if (bid >= NITEMS) return;
    float v[16];
    { const ConvDesc d0 = conv_desc(a, l, bid); conv_load(d0, v, wave, lane); }
    for (int it = bid; it < NITEMS; it += G) {
        __syncthreads();
#pragma unroll
        for (int i = 0; i < 16; ++i) tile[(wave * 16 + i) * 65 + lane] = v[i];
        __syncthreads();
        if (it + G < NITEMS) { const ConvDesc dn = conv_desc(a, l, it + G); conv_load(dn, v, wave, lane); }
        const ConvDesc c = conv_desc(a, l, it);
#pragma unroll
        for (int j = 0; j < 8; ++j) { const int n = wave * 8 + j; const float lo = tile[(2 * lane) * 65 + n], hi = tile[(2 * lane + 1) * 65 + n];
            if (c.W8) *(unsigned short*)(c.W8 + (size_t)(c.drow0 + n) * c.K + c.k0 + 2 * lane) = (unsigned short)(__builtin_amdgcn_cvt_pk_fp8_f32(lo, hi, 0, false) & 0xffff);
            else *(unsigned*)(c.WT + (size_t)(c.drow0 + n) * c.K + c.k0 + 2 * lane) = cvt_pk_b16(lo, hi); }
    }
}

__device__ __forceinline__ void prenorm_rows(const float* x, bf16_t* xn, float* rstd_out, int gw, int NGW, int lane) {
    for (int m = gw; m < M; m += NGW) {
        const float* xr = x + (size_t)m * DM; float v[32]; float ss = 0.f;
#pragma unroll
        for (int j = 0; j < 4; ++j) { const f32x4 a0 = *(const f32x4*)(xr + 512 * j + 8 * lane), a1 = *(const f32x4*)(xr + 512 * j + 8 * lane + 4);
#pragma unroll
            for (int e = 0; e < 4; ++e) { v[8 * j + e] = a0[e]; v[8 * j + 4 + e] = a1[e]; ss += a0[e] * a0[e] + a1[e] * a1[e]; } }
        const float rstd = rsqrtf(wave_sum(ss) * (1.0f / DM) + EPS);
#pragma unroll
        for (int j = 0; j < 4; ++j) {
            u32x4 w; w.x = cvt_pk_b16(v[8 * j + 0] * rstd, v[8 * j + 1] * rstd); w.y = cvt_pk_b16(v[8 * j + 2] * rstd, v[8 * j + 3] * rstd);
            w.z = cvt_pk_b16(v[8 * j + 4] * rstd, v[8 * j + 5] * rstd); w.w = cvt_pk_b16(v[8 * j + 6] * rstd, v[8 * j + 7] * rstd);
            *(u32x4*)(xn + (size_t)m * DM + 512 * j + 8 * lane) = w; }
        if (lane == 0) rstd_out[m] = rstd;
    }
}
__device__ __forceinline__ void resnorm_rows(const bf16_t* f, bf16_t* xn, float* rstd, float* hout32, float coef, const float* g_post, int gw, int NGW, int lane, unsigned char* xn8 = nullptr) {
    float gp[32];
#pragma unroll
    for (int j = 0; j < 4; ++j) { const f32x4 a0 = *(const f32x4*)(g_post + 512 * j + 8 * lane), a1 = *(const f32x4*)(g_post + 512 * j + 8 * lane + 4);
#pragma unroll
        for (int e = 0; e < 4; ++e) { gp[8 * j + e] = a0[e] * coef; gp[8 * j + 4 + e] = a1[e] * coef; } }
    u32x4 fw[4], hw[4]; float rprev = 1.0f;
#pragma unroll
    for (int j = 0; j < 4; ++j) { fw[j] = (u32x4){0u, 0u, 0u, 0u}; hw[j] = (u32x4){0u, 0u, 0u, 0u}; }
    auto issue = [&](int m) {
#pragma unroll
        for (int j = 0; j < 4; ++j) { const size_t off = (size_t)m * DM + 512 * j + 8 * lane; fw[j] = *(const u32x4*)(f + off); hw[j] = *(const u32x4*)(xn + off); }
        rprev = rstd[m]; };
    if (gw < M) issue(gw);
    for (int m = gw; m < M; m += NGW) {
        float fv[32], hv[32]; float ss = 0.f; const float hs = 1.0f / rprev;
#pragma unroll
        for (int j = 0; j < 4; ++j) { const u32x4 w = fw[j];
            fv[8 * j + 0] = bflo(w.x); fv[8 * j + 1] = bfhi(w.x); fv[8 * j + 2] = bflo(w.y); fv[8 * j + 3] = bfhi(w.y); fv[8 * j + 4] = bflo(w.z); fv[8 * j + 5] = bfhi(w.z); fv[8 * j + 6] = bflo(w.w); fv[8 * j + 7] = bfhi(w.w);
            const u32x4 h4 = hw[j];
            hv[8 * j + 0] = b16lo(h4.x) * hs; hv[8 * j + 1] = b16hi(h4.x) * hs; hv[8 * j + 2] = b16lo(h4.y) * hs; hv[8 * j + 3] = b16hi(h4.y) * hs; hv[8 * j + 4] = b16lo(h4.z) * hs; hv[8 * j + 5] = b16hi(h4.z) * hs; hv[8 * j + 6] = b16lo(h4.w) * hs; hv[8 * j + 7] = b16hi(h4.w) * hs;
#pragma unroll
            for (int e = 0; e < 8; ++e) ss += fv[8 * j + e] * fv[8 * j + e]; }
        if (m + NGW < M) issue(m + NGW);
        const float rs = rsqrtf(wave_sum(ss) * (1.0f / DM) + EPS);
        float ss2 = 0.f;
#pragma unroll
        for (int j = 0; j < 4; ++j) {
#pragma unroll
            for (int e = 0; e < 8; ++e) { const float o = hv[8 * j + e] + fv[8 * j + e] * rs * gp[8 * j + e]; ss2 += o * o; fv[8 * j + e] = o; }
            if (hout32) { const size_t off = (size_t)m * DM + 512 * j + 8 * lane;
                *(f32x4*)(hout32 + off) = (f32x4){fv[8 * j + 0], fv[8 * j + 1], fv[8 * j + 2], fv[8 * j + 3]}; *(f32x4*)(hout32 + off + 4) = (f32x4){fv[8 * j + 4], fv[8 * j + 5], fv[8 * j + 6], fv[8 * j + 7]}; } }
        if (!hout32) {
            const float rn = rsqrtf(wave_sum(ss2) * (1.0f / DM) + EPS);
#pragma unroll
            for (int j = 0; j < 4; ++j) {
                u32x4 w; w.x = cvt_pk_b16(fv[8 * j + 0] * rn, fv[8 * j + 1] * rn); w.y = cvt_pk_b16(fv[8 * j + 2] * rn, fv[8 * j + 3] * rn);
                w.z = cvt_pk_b16(fv[8 * j + 4] * rn, fv[8 * j + 5] * rn); w.w = cvt_pk_b16(fv[8 * j + 6] * rn, fv[8 * j + 7] * rn);
                *(u32x4*)(xn + (size_t)m * DM + 512 * j + 8 * lane) = w;
                if (xn8) { u32x2 b; b.x = pk_fp8x4(fv[8 * j + 0] * rn, fv[8 * j + 1] * rn, fv[8 * j + 2] * rn, fv[8 * j + 3] * rn); b.y = pk_fp8x4(fv[8 * j + 4] * rn, fv[8 * j + 5] * rn, fv[8 * j + 6] * rn, fv[8 * j + 7] * rn);
                    *(u32x2*)(xn8 + (size_t)m * DM + 512 * j + 8 * lane) = b; } }
            if (lane == 0) rstd[m] = rn;
        }
    }
}

__device__ __forceinline__ int rel_bucket(int dist) {
    if (dist < 16) return dist;
    const float d = (float)dist;
    int large = 16 + (int)(logf(d / 16.0f) / 4.852030263919617f * 16.0f);
    return large < 31 ? large : 31;
}

struct WinArgs {
    const bf16_t* q; const bf16_t* k; const bf16_t* v;
    long rstride;
    int first;
    int maxdist;
    const float* biascol; int dil;
    float sink; int has_sink;
    bf16_t* out; long ostride;
    float* lse; long lstride;
};
constexpr int AW_KS = 0, AW_VT = 36864, AW_PS = 36864 + 36864, AW_BT = AW_PS + 8 * 5376;
struct WinRegs { u32x4 k[4], v[4]; bf16x8 q0, q1; float bias; };
__device__ __forceinline__ void win_fetch(const WinArgs& A, int tid, int wave, int lane, WinRegs& R) {
#pragma unroll
    for (int i = 0; i < 4; ++i) {
        const int cidx = tid + 512 * i, j = cidx >> 3, part = cidx & 7;
        R.k[i] = (u32x4){0u, 0u, 0u, 0u}; R.v[i] = (u32x4){0u, 0u, 0u, 0u};
        if (!(A.first && j < 128)) { R.k[i] = *(const u32x4*)(A.k + (long)j * A.rstride + part * 8); R.v[i] = *(const u32x4*)(A.v + (long)j * A.rstride + part * 8); }
    }
    const bf16_t* qrow = A.q + (long)(16 * wave + (lane & 15)) * A.rstride;
    R.q0 = *(const bf16x8*)(qrow + 8 * (lane >> 4)); R.q1 = *(const bf16x8*)(qrow + 32 + 8 * (lane >> 4));
    R.bias = -3.0e38f;
    if (tid < 384) { const int dd = tid - 128; if (dd >= 0 && dd <= A.maxdist) R.bias = A.biascol[rel_bucket(dd * A.dil) * 20]; }
}
__device__ __forceinline__ void attn_win_item(LAS unsigned char* lds, const WinArgs& A, WinRegs& R, bool hasnext, const WinArgs& An, int tid, int wave, int lane) {
    LAS bf16_t* KS = (LAS bf16_t*)(lds + AW_KS);
    LAS bf16_t* VT = (LAS bf16_t*)(lds + AW_VT);
    LAS bf16_t* PS = (LAS bf16_t*)(lds + AW_PS) + wave * (16 * 168);
    LAS float* BT = (LAS float*)(lds + AW_BT);
    __syncthreads();
#pragma unroll
    for (int i = 0; i < 4; ++i) {
        const int cidx = tid + 512 * i, j = cidx >> 3, part = cidx & 7;
        *(LAS u32x4*)(KS + j * 72 + part * 8) = R.k[i];
        *(LAS u32x4*)(VT + j * 72 + part * 8) = R.v[i];
    }
    if (tid < 384) BT[tid] = R.bias;
    const bf16x8 qa0 = R.q0, qa1 = R.q1;
    __syncthreads();
    if (hasnext) win_fetch(An, tid, wave, lane, R);
    const int c = lane & 15, g = lane >> 4, st = wave < 6 ? wave : 6;
    f32x4 s[10];
#pragma unroll
    for (int jt = 0; jt < 10; ++jt) {
        const LAS bf16_t* kr = KS + (16 * (st + jt) + c) * 72 + 8 * g;
        const bf16x8 kb0 = *(const LAS bf16x8*)kr, kb1 = *(const LAS bf16x8*)(kr + 32);
        f32x4 z = (f32x4){0.f, 0.f, 0.f, 0.f};
        z = MFMA16(qa0, kb0, z);
        z = MFMA16(qa1, kb1, z);
        s[jt] = z;
    }
    float mx[4] = {-3.0e38f, -3.0e38f, -3.0e38f, -3.0e38f};
    { const LAS float* bp = BT + (16 * wave + 4 * g - 16 * st - c + 256 - 144);
#pragma unroll
      for (int jt = 0; jt < 10; ++jt) {
#pragma unroll
          for (int i = 0; i < 4; ++i) { const float lg = s[jt][i] * 0.125f + bp[144 + i - 16 * jt]; s[jt][i] = lg; mx[i] = fmaxf(mx[i], lg); } }
      if (A.first) {
#pragma unroll
          for (int jt = 0; jt < 10; ++jt) { if (16 * (st + jt) + c < 128) {
#pragma unroll
              for (int i = 0; i < 4; ++i) s[jt][i] = -3.0e38f; } }
#pragma unroll
          for (int i = 0; i < 4; ++i) { mx[i] = -3.0e38f;
#pragma unroll
              for (int jt = 0; jt < 10; ++jt) mx[i] = fmaxf(mx[i], s[jt][i]); } } }
#pragma unroll
    for (int i = 0; i < 4; ++i) {
        mx[i] = row16_max(mx[i]);
        if (A.has_sink) mx[i] = fmaxf(mx[i], A.sink);
    }
    float sm[4] = {0.f, 0.f, 0.f, 0.f};
#pragma unroll
    for (int jt = 0; jt < 10; ++jt) {
#pragma unroll
        for (int i = 0; i < 4; ++i) {
            const float p = __expf(s[jt][i] - mx[i]);
            sm[i] += p;
            PS[(4 * g + i) * 168 + 16 * jt + c] = f2bf(p);
        }
    }
#pragma unroll
    for (int i = 0; i < 4; ++i) {
        sm[i] = row16_sum(sm[i]);
        if (A.has_sink) sm[i] += __expf(A.sink - mx[i]);
    }
    LDS_WAIT();
    f32x4 o[4];
#pragma unroll
    for (int dt = 0; dt < 4; ++dt) o[dt] = (f32x4){0.f, 0.f, 0.f, 0.f};
    const unsigned vaddr = lds_addr(VT + (16 * st + 8 * g + (c >> 2)) * 72 + 4 * (c & 3));
#pragma unroll
    for (int ks = 0; ks < 5; ++ks) {
        const bf16x8 pa = *(const LAS bf16x8*)(PS + c * 168 + 32 * ks + 8 * g);
        bf16x8 vb[4]; tr_frag4<576>(vaddr + ks * (32 * 144), vb);
#pragma unroll
        for (int dt = 0; dt < 4; ++dt) o[dt] = MFMA16(pa, vb[dt], o[dt]);
    }
#pragma unroll
    for (int i = 0; i < 4; ++i) {
        const float inv = 1.0f / sm[i];
        bf16_t* orow = A.out + (long)(16 * wave + 4 * g + i) * A.ostride;
#pragma unroll
        for (int dt = 0; dt < 4; ++dt) orow[16 * dt + c] = A.has_sink ? f2b16(o[dt][i] * inv) : f2bf(o[dt][i] * inv);
        if (A.lse && c == 0) A.lse[(long)(16 * wave + 4 * g + i) * A.lstride] = mx[i] + __logf(sm[i]);
    }
}

constexpr float SB_THR = -30.0f;
constexpr int SB_KS = 0, SB_VT = 18432, SB_PS = 18432 + 18432;
__device__ __forceinline__ void stickbreak_item(LAS unsigned char* lds, volatile LAS unsigned* flag, const bf16_t* proj, bf16_t* yall, int b, int h, int nb, int tid, int wave, int lane) {
    LAS bf16_t* KS = (LAS bf16_t*)(lds + SB_KS);
    LAS bf16_t* VT = (LAS bf16_t*)(lds + SB_VT);
    LAS bf16_t* PS = (LAS bf16_t*)(lds + SB_PS) + wave * (16 * 136);
    const int c = lane & 15, g = lane >> 4;
    const long tok0 = (long)b * SEQ + 128 * nb;
    const bf16_t* qrow = proj + (tok0 + 16 * wave + c) * MIXIN + BQ + h * 64;
    const bf16x8 qa0 = *(const bf16x8*)(qrow + 8 * g), qa1 = *(const bf16x8*)(qrow + 32 + 8 * g);
    float R[4] = {0.f, 0.f, 0.f, 0.f};
    f32x4 o[4];
#pragma unroll
    for (int dt = 0; dt < 4; ++dt) o[dt] = (f32x4){0.f, 0.f, 0.f, 0.f};
    bool wdone = false;
    if (tid == 0) flag[0] = 0u;
    for (int kb = nb; kb >= 0; --kb) {
        __syncthreads();
        const bf16_t* kbase = proj + ((long)b * SEQ + 128 * kb) * MIXIN + h * 64;
#pragma unroll
        for (int i = 0; i < 2; ++i) {
            const int cidx = tid + 512 * i, j = cidx >> 3, part = cidx & 7;
            const u32x4 kw = *(const u32x4*)(kbase + (long)j * MIXIN + BKo + part * 8), vw = *(const u32x4*)(kbase + (long)j * MIXIN + BVo + part * 8);
            *(LAS u32x4*)(KS + j * 72 + part * 8) = kw;
            *(LAS u32x4*)(VT + j * 72 + part * 8) = vw;
        }
        __syncthreads();
        if (!wdone) {
            const bool diag = (kb == nb);
            const int jt_hi = diag ? wave : 7;
            if (diag) { for (int jt = wave + 1; jt < 8; ++jt) {
#pragma unroll
                    for (int i = 0; i < 4; ++i) PS[(4 * g + i) * 136 + 16 * jt + c] = 0; } }
            for (int jt = jt_hi; jt >= 0; --jt) {
                const LAS bf16_t* kr = KS + (16 * jt + c) * 72 + 8 * g;
                const bf16x8 kb0 = *(const LAS bf16x8*)kr, kb1 = *(const LAS bf16x8*)(kr + 32);
                f32x4 z = (f32x4){0.f, 0.f, 0.f, 0.f};
                z = MFMA16(qa0, kb0, z);
                z = MFMA16(qa1, kb1, z);
#pragma unroll
                for (int i = 0; i < 4; ++i) {
                    const float zz = z[i] * 0.125f;
                    const bool past = !diag || jt < wave || c < 4 * g + i;
                    const float sp = fmaxf(zz, 0.f) + __logf(1.0f + __expf(-fabsf(zz)));
                    const float lk = past ? -sp : 0.f;
                    float inc = lk;
                    inc += dpp_f<0x101>(inc); inc += dpp_f<0x102>(inc); inc += dpp_f<0x104>(inc); inc += dpp_f<0x108>(inc);
                    const float between = R[i] + inc - lk;
                    const float a = past ? __expf(zz - sp + between) : 0.f;
                    R[i] += row16_sum(lk);
                    PS[(4 * g + i) * 136 + 16 * jt + c] = f2bf(a);
                }
                if (jt > 0 && __all(fmaxf(fmaxf(R[0], R[1]), fmaxf(R[2], R[3])) < SB_THR)) {
                    for (int j2 = jt - 1; j2 >= 0; --j2) {
#pragma unroll
                        for (int i = 0; i < 4; ++i) PS[(4 * g + i) * 136 + 16 * j2 + c] = 0; }
                    break; }
            }
            LDS_WAIT();
#pragma unroll
            for (int ks = 0; ks < 4; ++ks) {
                const bf16x8 pa = *(const LAS bf16x8*)(PS + c * 136 + 32 * ks + 8 * g);
                bf16x8 vb[4]; tr_frag4<576>(lds_addr(VT + (8 * g + (c >> 2)) * 72 + 4 * (c & 3)) + ks * (32 * 144), vb);
#pragma unroll
                for (int dt = 0; dt < 4; ++dt) o[dt] = MFMA16(pa, vb[dt], o[dt]);
            }
            const float rmax = fmaxf(fmaxf(R[0], R[1]), fmaxf(R[2], R[3]));
            wdone = __all(rmax < SB_THR);
        }
        if (!wdone && lane == 0) flag[0] = (unsigned)(kb + 1);
        __syncthreads();
        if (flag[0] != (unsigned)(kb + 1)) break;
    }
#pragma unroll
    for (int i = 0; i < 4; ++i) {
        bf16_t* orow = yall + (tok0 + 16 * wave + 4 * g + i) * BRT + 512 + h * 64;
#pragma unroll
        for (int dt = 0; dt < 4; ++dt) orow[16 * dt + c] = f2b16(o[dt][i]);
    }
}

constexpr int H1_GT = 0, H1_BR = 2048, H1_BL = 2560, H1_QS = 3072, H1_KS = H1_QS + 33792, H1_KDT = H1_KS + 33792, H1_VT = H1_KDT + 18432, H1_PS = H1_VT + 18432;
__device__ __forceinline__ void hgrn_a1_load(const Args& a, int item, int tid, unsigned (&fq)[16], unsigned (&vp)[8]) {
    const bf16_t* proj = (const bf16_t*)(a.ws + WS_PROJ);
    const int cch = item & 63, h = (item >> 6) & 3, b = item >> 8, k = tid & 127, rg = tid >> 7;
    const bf16_t* p = proj + ((long)b * SEQ + 64 * cch + 16 * rg) * MIXIN + h * 128 + k;
#pragma unroll
    for (int r = 0; r < 16; ++r) { const unsigned f = p[(long)r * MIXIN + AF], q = p[(long)r * MIXIN + AQ], v = p[(long)r * MIXIN + AI]; fq[r] = f | (q << 16); if (r & 1) vp[r >> 1] |= v << 16; else vp[r >> 1] = v; }
}
__device__ __forceinline__ void hgrn_a1_item(LAS unsigned char* lds, const Args& a, int l, int item, int next_item, unsigned (&fq)[16], unsigned (&vp)[8], int tid, int wave, int lane) {
    const int cch = item & 63, h = (item >> 6) & 3, b = item >> 8;
    const long tok0 = (long)b * SEQ + 64 * cch;
    LAS float* GT = (LAS float*)(lds + H1_GT);
    LAS float* BR = (LAS float*)(lds + H1_BR);
    LAS float* BL = (LAS float*)(lds + H1_BL);
    LAS float* QS = (LAS float*)(lds + H1_QS);
    LAS float* KS = (LAS float*)(lds + H1_KS);
    LAS bf16_t* KDT = (LAS bf16_t*)(lds + H1_KDT);
    LAS bf16_t* VT = (LAS bf16_t*)(lds + H1_VT);
    LAS bf16_t* PS = (LAS bf16_t*)(lds + H1_PS);
    const int k = tid & 127, rg = tid >> 7;
    float lb;
    { const float* lg = a.lb_logits + h * 128 + k; const float l0 = lg[0], l1 = lg[512], l2 = lg[1024], l3 = lg[1536];
      const float mxl = fmaxf(fmaxf(l0, l1), fmaxf(l2, l3)); const float e0 = __expf(l0 - mxl), e1 = __expf(l1 - mxl), e2 = __expf(l2 - mxl), e3 = __expf(l3 - mxl);
      const float inv = 1.0f / (e0 + e1 + e2 + e3);
      lb = (l >= 1 ? e1 : 0.f) + (l >= 2 ? e2 : 0.f) + (l >= 3 ? e3 : 0.f); lb *= inv; }
    __syncthreads();
    float kk[16], bb[16];
    { float run = 0.f;
#pragma unroll
      for (int r = 0; r < 16; ++r) { const float fl = bf2f((bf16_t)(fq[r] & 0xffffu));
          const float f = lb + (1.0f - lb) * fast_sigmoid(fl); kk[r] = 1.0f - f; run += __logf(f); bb[r] = run; }
      GT[rg * 128 + k] = run; }
    __syncthreads();
    { float pre = 0.f;
#pragma unroll
      for (int r2 = 0; r2 < 3; ++r2) pre += (r2 < rg) ? GT[r2 * 128 + k] : 0.f;
#pragma unroll
      for (int r = 0; r < 16; ++r) bb[r] += pre;
      if (rg == 1) BR[k] = bb[15];
      if (rg == 3) BL[k] = bb[15]; }
    __syncthreads();
    { const float bref = BR[k], blast = BL[k];
      bf16_t* qi_out = (bf16_t*)(a.ws + WS_QI) + ((size_t)item * 64 + 16 * rg) * 128 + k;
      unsigned kd[8];
#pragma unroll
      for (int r = 0; r < 16; ++r) {
          const float q = bf2f((bf16_t)(fq[r] >> 16));
          const float qs = q * __expf(bb[r] - bref), ks = kk[r] * __expf(bref - bb[r]), kdv = kk[r] * __expf(blast - bb[r]), qi = q * __expf(bb[r]);
          QS[(16 * rg + r) * 132 + k] = qs; KS[(16 * rg + r) * 132 + k] = ks;
          qi_out[(size_t)r * 128] = f2bf(qi);
          const unsigned kdb = f2bf(kdv);
          if (r & 1) kd[r >> 1] |= kdb << 16; else kd[r >> 1] = kdb;
      }
      *(LAS u32x4*)(KDT + k * 72 + 16 * rg) = (u32x4){kd[0], kd[1], kd[2], kd[3]}; *(LAS u32x4*)(KDT + k * 72 + 16 * rg + 8) = (u32x4){kd[4], kd[5], kd[6], kd[7]};
      *(LAS u32x4*)(VT + k * 72 + 16 * rg) = (u32x4){vp[0], vp[1], vp[2], vp[3]}; *(LAS u32x4*)(VT + k * 72 + 16 * rg + 8) = (u32x4){vp[4], vp[5], vp[6], vp[7]};
      if (rg == 3) ((float*)(a.ws + WS_DC))[(size_t)item * 128 + k] = __expf(blast); }
    if (next_item >= 0) hgrn_a1_load(a, next_item, tid, fq, vp);
    __syncthreads();
    const int c = lane & 15, g = lane >> 4;
    { const int mt = wave >> 1;
#pragma unroll
      for (int e = 0; e < 2; ++e) { const int nt = 2 * (wave & 1) + e;
          f32x4 z = (f32x4){0.f, 0.f, 0.f, 0.f};
          if (nt <= mt) {
#pragma unroll
              for (int Mi = 0; Mi < 8; ++Mi) { const f32x4 a4 = *(const LAS f32x4*)(QS + (16 * mt + c) * 132 + 16 * Mi + 4 * g), b4 = *(const LAS f32x4*)(KS + (16 * nt + c) * 132 + 16 * Mi + 4 * g);
#pragma unroll
                  for (int j = 0; j < 4; ++j) z = __builtin_amdgcn_mfma_f32_16x16x4f32(a4[j], b4[j], z, 0, 0, 0); } }
#pragma unroll
          for (int i = 0; i < 4; ++i) { const int t = 16 * mt + 4 * g + i, s = 16 * nt + c; PS[t * 72 + s] = (s <= t) ? f2bf(z[i]) : (bf16_t)0; } } }
    __syncthreads();
    { const int mt = wave >> 1;
      bf16_t* oi = (bf16_t*)(a.ws + WS_OINTRA) + (size_t)item * 64 * 128;
      bf16x8 pa[2];
#pragma unroll
      for (int ks = 0; ks < 2; ++ks) pa[ks] = *(const LAS bf16x8*)(PS + (16 * mt + c) * 72 + 32 * ks + 8 * g);
#pragma unroll
      for (int e = 0; e < 4; ++e) { const int vt = 4 * (wave & 1) + e; f32x4 z = (f32x4){0.f, 0.f, 0.f, 0.f};
#pragma unroll
          for (int ks = 0; ks < 2; ++ks) { const bf16x8 vb = *(const LAS bf16x8*)(VT + (16 * vt + c) * 72 + 32 * ks + 8 * g); z = MFMA16(vb, pa[ks], z); }
          u32x2 w; w.x = cvt_pk_bf16(z[0], z[1]); w.y = cvt_pk_bf16(z[2], z[3]); *(u32x2*)(oi + (size_t)(16 * mt + c) * 128 + 16 * vt + 4 * g) = w; }
      bf16_t* U = (bf16_t*)(a.ws + WS_U) + (size_t)item * 128 * 128;
      bf16x8 ka[2];
#pragma unroll
      for (int ks = 0; ks < 2; ++ks) ka[ks] = *(const LAS bf16x8*)(KDT + (16 * wave + c) * 72 + 32 * ks + 8 * g);
#pragma unroll
      for (int vt = 0; vt < 8; ++vt) { f32x4 z = (f32x4){0.f, 0.f, 0.f, 0.f};
#pragma unroll
          for (int ks = 0; ks < 2; ++ks) { const bf16x8 vb = *(const LAS bf16x8*)(VT + (16 * vt + c) * 72 + 32 * ks + 8 * g); z = MFMA16(vb, ka[ks], z); }
          u32x2 w; w.x = cvt_pk_bf16(z[0], z[1]); w.y = cvt_pk_bf16(z[2], z[3]); *(u32x2*)(U + (size_t)(16 * wave + c) * 128 + 16 * vt + 4 * g) = w; } }
}
__device__ __forceinline__ void hgrn_a2(const Args& a, int gtid, int gthreads) {
    const bf16_t* U = (const bf16_t*)(a.ws + WS_U); const float* DC = (const float*)(a.ws + WS_DC); bf16_t* SP = (bf16_t*)(a.ws + WS_SPREV);
    for (int e = gtid; e < 32 * 128 * 32; e += gthreads) {
        const int v4 = e & 31, k = (e >> 5) & 127, bh = e >> 12;
        f32x4 S = (f32x4){0.f, 0.f, 0.f, 0.f};
        u32x2 ub[8]; float db[8];
#pragma unroll
        for (int j = 0; j < 8; ++j) { const size_t it = (size_t)bh * 64 + j; ub[j] = *(const u32x2*)(U + (it * 128 + k) * 128 + 4 * v4); db[j] = DC[it * 128 + k]; }
        for (int c0 = 0; c0 < 64; c0 += 8) {
#pragma unroll
            for (int j = 0; j < 8; ++j) {
                const size_t it = (size_t)bh * 64 + c0 + j;
                const u32x2 uw = ub[j]; const float d = db[j];
                if (c0 + 8 < 64) { const size_t itn = it + 8; ub[j] = *(const u32x2*)(U + (itn * 128 + k) * 128 + 4 * v4); db[j] = DC[itn * 128 + k]; }
                const f32x4 u = (f32x4){bflo(uw.x), bfhi(uw.x), bflo(uw.y), bfhi(uw.y)};
                u32x2 w; w.x = cvt_pk_bf16(S[0], S[1]); w.y = cvt_pk_bf16(S[2], S[3]);
                *(u32x2*)(SP + (it * 128 + k) * 128 + 4 * v4) = w;
                S = S * d + u;
            }
        }
    }
}
constexpr int H3_ST = 0, H3_SS = 36864;
__device__ __forceinline__ void hgrn_a3_item(LAS unsigned char* lds, const Args& a, int l, int item, int tid, int wave, int lane) {
    const bf16_t* proj = (const bf16_t*)(a.ws + WS_PROJ); bf16_t* yall = (bf16_t*)(a.ws + WS_YALL);
    const int cch = item & 63, h = (item >> 6) & 3, b = item >> 8;
    const long tok0 = (long)b * SEQ + 64 * cch;
    LAS bf16_t* ST = (LAS bf16_t*)(lds + H3_ST); LAS float* SS = (LAS float*)(lds + H3_SS);
    const bf16_t* SP = (const bf16_t*)(a.ws + WS_SPREV) + (size_t)item * 128 * 128;
    __syncthreads();
#pragma unroll
    for (int i = 0; i < 4; ++i) { const int cidx = tid + 512 * i, kr = cidx >> 4, part = cidx & 15;
        const u32x4 w = *(const u32x4*)(SP + (size_t)kr * 128 + 8 * part);
        *(LAS u32x4*)(ST + kr * 144 + 8 * part) = w; }
    __syncthreads();
    const int c = lane & 15, g = lane >> 4, mt = wave >> 1;
    const bf16_t* qi = (const bf16_t*)(a.ws + WS_QI) + ((size_t)item * 64 + 16 * mt + c) * 128;
    const bf16_t* oi = (const bf16_t*)(a.ws + WS_OINTRA) + (size_t)item * 64 * 128;
    bf16x8 qa[4];
#pragma unroll
    for (int ks = 0; ks < 4; ++ks) qa[ks] = *(const bf16x8*)(qi + 32 * ks + 8 * g);
    f32x4 o[4];
#pragma unroll
    for (int e = 0; e < 4; ++e) o[e] = (f32x4){0.f, 0.f, 0.f, 0.f};
    { const unsigned saddr = lds_addr(ST + (8 * g + (c >> 2)) * 144 + 64 * (wave & 1) + 4 * (c & 3));
#pragma unroll
      for (int ks = 0; ks < 4; ++ks) { bf16x8 sb[4]; tr_frag4<1152>(saddr + ks * (32 * 288), sb);
#pragma unroll
          for (int e = 0; e < 4; ++e) o[e] = MFMA16(sb[e], qa[ks], o[e]); } }
    const int t = 16 * mt + c; float ss = 0.f;
#pragma unroll
    for (int e = 0; e < 4; ++e) { const int v0 = 16 * (4 * (wave & 1) + e) + 4 * g; const u32x2 w = *(const u32x2*)(oi + (size_t)t * 128 + v0);
        f32x4 z = o[e]; z[0] += bflo(w.x); z[1] += bfhi(w.x); z[2] += bflo(w.y); z[3] += bfhi(w.y);
        ss += (z[0] * z[0] + z[1] * z[1]) + (z[2] * z[2] + z[3] * z[3]); o[e] = z; }
    ss += __shfl_xor(ss, 16); ss += __shfl_xor(ss, 32);
    if (g == 0) SS[t * 2 + (wave & 1)] = ss;
    __syncthreads();
    { const float rstd = rsqrtf((SS[t * 2] + SS[t * 2 + 1]) * (1.0f / 128.0f) + EPS);
      const long tok = tok0 + t;
#pragma unroll
      for (int e = 0; e < 4; ++e) { const int v0 = 16 * (4 * (wave & 1) + e) + 4 * g;
          const u32x2 gw = *(const u32x2*)(proj + tok * MIXIN + AG + h * 128 + v0); const f32x4 ng = *(const f32x4*)(a.hgrn_norm + l * 128 + v0);
          const float gt[4] = {bflo(gw.x), bfhi(gw.x), bflo(gw.y), bfhi(gw.y)}; float y[4];
#pragma unroll
          for (int i = 0; i < 4; ++i) y[i] = o[e][i] * rstd * ng[i] * (gt[i] * fast_sigmoid(gt[i]));
          u32x2 w; w.x = cvt_pk_b16(y[0], y[1]); w.y = cvt_pk_b16(y[2], y[3]); *(u32x2*)(yall + tok * BRT + h * 128 + v0) = w; } }
}
__device__ __forceinline__ void c_combine(const Args& a, int gtid, int gthreads) {
    const bf16_t* CP = (const bf16_t*)(a.ws + WS_CPART); const float* LS = (const float*)(a.ws + WS_CLSE); bf16_t* yall = (bf16_t*)(a.ws + WS_YALL);
    for (int e = gtid; e < M * 32; e += gthreads) {
        const int part = e & 31, tok = e >> 5, h4 = part >> 3;
        const float l0 = LS[(size_t)tok * 4 + h4], l1 = LS[((size_t)M + tok) * 4 + h4], l2 = LS[((size_t)2 * M + tok) * 4 + h4];
        const float mx = fmaxf(l0, fmaxf(l1, l2)); float w0 = __expf(l0 - mx), w1 = __expf(l1 - mx), w2 = __expf(l2 - mx); const float inv = 1.0f / (w0 + w1 + w2); w0 *= inv; w1 *= inv; w2 *= inv;
        const u32x4 p0 = *(const u32x4*)(CP + (size_t)tok * 256 + 8 * part), p1 = *(const u32x4*)(CP + ((size_t)M + tok) * 256 + 8 * part), p2 = *(const u32x4*)(CP + ((size_t)2 * M + tok) * 256 + 8 * part);
        u32x4 o;
        o.x = cvt_pk_b16(w0 * bflo(p0.x) + w1 * bflo(p1.x) + w2 * bflo(p2.x), w0 * bfhi(p0.x) + w1 * bfhi(p1.x) + w2 * bfhi(p2.x));
        o.y = cvt_pk_b16(w0 * bflo(p0.y) + w1 * bflo(p1.y) + w2 * bflo(p2.y), w0 * bfhi(p0.y) + w1 * bfhi(p1.y) + w2 * bfhi(p2.y));
        o.z = cvt_pk_b16(w0 * bflo(p0.z) + w1 * bflo(p1.z) + w2 * bflo(p2.z), w0 * bfhi(p0.z) + w1 * bfhi(p1.z) + w2 * bfhi(p2.z));
        o.w = cvt_pk_b16(w0 * bflo(p0.w) + w1 * bflo(p1.w) + w2 * bflo(p2.w), w0 * bfhi(p0.w) + w1 * bfhi(p1.w) + w2 * bfhi(p2.w));
        *(u32x4*)(yall + (size_t)tok * BRT + 1024 + 8 * part) = o;
    }
}

__device__ __forceinline__ WinArgs win_args_c(const Args& a, const bf16_t* proj, int it) {
    const int sub = it & 31, h4 = (it >> 5) & 3, bg = it >> 7, g = bg % 3, b = bg / 3;
    const int r = g == 0 ? 1 : (g == 1 ? 4 : 16); const int nper = 32 / r, res = sub / nper, n = sub % nper;
    const long tq = (long)b * SEQ + (long)(128 * n) * r + res, tk = tq - (long)128 * r;
    WinArgs W; W.q = proj + tq * MIXIN + CQ + g * 256 + h4 * 64; W.k = proj + tk * MIXIN + CKo + g * 256 + h4 * 64; W.v = proj + tk * MIXIN + CVo + g * 256 + h4 * 64;
    W.rstride = (long)r * MIXIN; W.first = (n == 0); W.maxdist = 128; W.biascol = a.rel_bias + g * 4 + h4; W.dil = r; W.sink = 0.f; W.has_sink = 0;
    W.out = (bf16_t*)(a.ws + WS_CPART) + ((size_t)g * M + tq) * 256 + h4 * 64; W.ostride = (long)r * 256;
    W.lse = (float*)(a.ws + WS_CLSE) + ((size_t)g * M + tq) * 4 + h4; W.lstride = (long)r * 4;
    return W;
}
__device__ __forceinline__ WinArgs win_args_d(const Args& a, const bf16_t* proj, bf16_t* yall, int l, int it) {
    const int nb = it & 31, hq = (it >> 5) & 7, b = it >> 8, kvh = hq >> 2;
    const long tq = (long)b * SEQ + 128 * nb, tk = tq - 128;
    WinArgs W; W.q = proj + tq * MIXIN + DQo + hq * 64; W.k = proj + tk * MIXIN + DKo + kvh * 64; W.v = proj + tk * MIXIN + DVo + kvh * 64;
    W.rstride = MIXIN; W.first = (nb == 0); W.maxdist = 127; W.biascol = a.rel_bias + 12 + hq; W.dil = 1; W.sink = a.sinks[l * 8 + hq]; W.has_sink = 1;
    W.out = yall + tq * BRT + 1280 + hq * 64; W.ostride = BRT; W.lse = nullptr; W.lstride = 0;
    return W;
}

constexpr int LDS_BYTES = 147456;
constexpr int LDS_MISC = 131072;
constexpr int NPH = 14;

__global__ void __launch_bounds__(512, 2) fwd_kernel(Args a) {
    extern __shared__ __attribute__((aligned(16))) unsigned char lds_raw[];
    LAS unsigned char* lds = (LAS unsigned char*)lds_raw;
    const int G = gridDim.x, bid = blockIdx.x;
    const int NGW = G * 8, gthreads = G * 512;
#define LAUNDER() int tid_ = threadIdx.x; asm volatile("" : "+v"(tid_)); const int tid = tid_, lane = tid & 63, wave = __builtin_amdgcn_readfirstlane(tid >> 6), gw = bid * 8 + wave, gtid = bid * 512 + tid; (void)lane; (void)gw; (void)gtid
    unsigned char* ws = a.ws;
    volatile LAS unsigned* MISC = (volatile LAS unsigned*)(lds + LDS_MISC);
    if (threadIdx.x < 64) MISC[threadIdx.x] = 0u;
    __syncthreads();
#if MK_ONE_LAUNCH
    XcdBarrier bar = xcd_barrier_post((unsigned*)(ws + WS_CTL) + CW_BAR, MISC + 8);
#define GRID_BAR() xcd_barrier(bar)
#else
#define GRID_BAR() do { } while (0)
#endif
    bf16_t* XN = (bf16_t*)(ws + WS_H16);
    float* RSTD = (float*)(ws + WS_CTL + 512 * 1024);
    for (int l = a.l_lo; l < a.l_hi; ++l) {
        const int lo = a.ph_lo, hi = a.ph_hi;
#define IN(k) (((PHMASK >> (k)) & 1) && lo <= (k) && (k) < hi)
        if (IN(0) && l == 0) {
            LAUNDER();
            convert_weights(a, 0, lds, bid, G, lane, wave);
            prenorm_rows(a.x, XN, RSTD, gw, NGW, lane);
            GRID_BAR();
        }
        if (IN(1)) for (int rep_ = 0; rep_ < (((RPT_MASK >> 1) & 1) ? 2 : 1); ++rep_) {
            LAUNDER();
            pg8::SchedPlain S; S.o.init(M / 256, 2 * DFF / 256, G, bid, COLCH); S.A = (const char*)XN; S.B = (const char*)(ws + WS_W13A); S.tstepA = (size_t)256 * DM * 2; S.tstepB = (size_t)256 * DM * 2; S.nt = DM / 64;
            pg8::EpiSwiglu E{(bf16_t*)(ws + WS_ACT), DFF};
            pg8::gemm_phase<false, GSP2, GALIGN>(lds, DM, DM, S, E);
            GRID_BAR();
        }
        if (IN(2)) for (int rep_ = 0; rep_ < (((RPT_MASK >> 2) & 1) ? 2 : 1); ++rep_) {
            LAUNDER();
            pg8::SchedPlain S; S.o.init(M / 256, DM / 256, G, bid, 1); S.A = (const char*)(ws + WS_ACT); S.B = (const char*)(ws + WS_W2A); S.tstepA = (size_t)256 * DFF * 2; S.tstepB = (size_t)256 * DFF * 2; S.nt = DFF / 64;
            pg8::EpiBf16 E{(bf16_t*)(ws + WS_F_FFN), DM};
            pg8::gemm_phase<false, GSP2, GALIGN>(lds, DFF, DFF, S, E);
            GRID_BAR();
        }
        if (IN(3)) {
            LAUNDER();
            resnorm_rows((const bf16_t*)(ws + WS_F_FFN), XN, RSTD, nullptr, 0.5f, a.ffn1_norm + (size_t)(l * 2 + 1) * DM, gw, NGW, lane, ws + WS_XN8);
            GRID_BAR();
        }
        if (IN(4)) for (int rep_ = 0; rep_ < (((RPT_MASK >> 4) & 1) ? 2 : 1); ++rep_) {
            LAUNDER();
#ifndef NO_PROJ
            {
                pg8::SchedPlain S; S.o.init(M / 256, MIXIN / 256, G, bid, COLCH); S.A = (const char*)XN; S.B = (const char*)(ws + WS_WIN); S.tstepA = (size_t)256 * DM * 2; S.tstepB = (size_t)256 * DM * 2; S.nt = DM / 64;
                pg8::EpiBf16 E{(bf16_t*)(ws + WS_PROJ), MIXIN};
                pg8::gemm_phase<false, GSP2, GALIGN>(lds, DM, DM, S, E); }
#endif
#ifndef NO_G8
            {
                constexpr int NB8 = ((F8MASK >> 0) & 1) + ((F8MASK >> 1) & 1) + ((F8MASK >> 2) & 1) + ((F8MASK >> 3) & 1);
                if constexpr (NB8 > 0) {
                pg8::SchedPlain S; S.o.init(M / 256, 8 * NB8, G, bid, COLCH); S.A = (const char*)(ws + WS_XN8); S.B = (const char*)(ws + WS_WG8); S.tstepA = (size_t)256 * DM; S.tstepB = (size_t)256 * DM; S.nt = DM / 128; S.bmap = branch_list(F8MASK);
                pg8::EpiGates E{ws + WS_GATES, 1.0f / GATE_WSCALE};
                pg8::gemm_phase<true, GSP2, GALIGN>(lds, DM / 2, DM / 2, S, E); }
                if constexpr (NB8 < 4) {
                pg8::SchedPlain S; S.o.init(M / 256, 8 * (4 - NB8), G, bid, COLCH); S.A = (const char*)XN; S.B = (const char*)(ws + WS_WIN) + (size_t)MIXIN * DM * 2; S.tstepA = (size_t)256 * DM * 2; S.tstepB = (size_t)256 * DM * 2; S.nt = DM / 64; S.bmap = branch_list(~F8MASK & 15);
                pg8::EpiGates E{ws + WS_GATES, 1.0f};
                pg8::gemm_phase<false, GSP2, GALIGN>(lds, DM, DM, S, E); } }
#endif
            GRID_BAR();
        }
        if (IN(5)) for (int rep_ = 0; rep_ < (((RPT_MASK >> 5) & 1) ? 2 : 1); ++rep_) {
            LAUNDER();
            const bf16_t* proj = (const bf16_t*)(ws + WS_PROJ); bf16_t* yall = (bf16_t*)(ws + WS_YALL);
            { unsigned fq[16], vp[8];
#pragma unroll
              for (int r = 0; r < 16; ++r) { fq[r] = 0u; vp[r >> 1] = 0u; }
              for (int it = bid; it < 2048; it += G) { hgrn_a1_load(a, it, tid, fq, vp); hgrn_a1_item(lds, a, l, it, -1, fq, vp, tid, wave, lane); } }
            __syncthreads();
            for (int it = bid; it < 2048; it += G) { const int nb = 31 - (it & 31), h = (it >> 5) & 7, b = it >> 8; stickbreak_item(lds, MISC + 16, proj, yall, b, h, nb, tid, wave, lane); }
            __syncthreads();
            { WinRegs R; WinArgs W = win_args_c(a, proj, bid);
              win_fetch(W, tid, wave, lane, R);
              for (int it = bid; it < 3072; it += G) { const bool hn = it + G < 3072; const WinArgs Wn = win_args_c(a, proj, hn ? it + G : it);
                  attn_win_item(lds, W, R, hn, Wn, tid, wave, lane); W = Wn; } }
            __syncthreads();
            { WinRegs R; WinArgs W = win_args_d(a, proj, yall, l, bid);
              win_fetch(W, tid, wave, lane, R);
              for (int it = bid; it < 2048; it += G) { const bool hn = it + G < 2048; const WinArgs Wn = win_args_d(a, proj, yall, l, hn ? it + G : it);
                  attn_win_item(lds, W, R, hn, Wn, tid, wave, lane); W = Wn; } }
            GRID_BAR();
        }
        if (IN(6)) for (int rep_ = 0; rep_ < (((RPT_MASK >> 6) & 1) ? 2 : 1); ++rep_) {
            LAUNDER();
            hgrn_a2(a, gtid, gthreads);
            c_combine(a, gtid, gthreads);
            GRID_BAR();
        }
        if (IN(7)) for (int rep_ = 0; rep_ < (((RPT_MASK >> 7) & 1) ? 2 : 1); ++rep_) {
            LAUNDER();
            for (int it = bid; it < 2048; it += G) hgrn_a3_item(lds, a, l, it, tid, wave, lane);
            GRID_BAR();
        }
        if (IN(8)) for (int rep_ = 0; rep_ < (((RPT_MASK >> 8) & 1) ? 2 : 1); ++rep_) {
            LAUNDER();
            pg8::SchedBranch S; S.o.init(M / 256, DM / 256, G, bid); S.A = (const char*)(ws + WS_YALL); S.B = (const char*)(ws + WS_WBR); S.tstepA = (size_t)256 * BRT * 2; S.tstepB = (size_t)256 * BRT * 2;
            pg8::EpiBranch E{(bf16_t*)(ws + WS_MERGED), ws + WS_GATES};
            pg8::gemm_phase<false, GSP2, GALIGN>(lds, BRT, BRT, S, E);
            GRID_BAR();
        }
        if (IN(9)) for (int rep_ = 0; rep_ < (((RPT_MASK >> 9) & 1) ? 2 : 1); ++rep_) {
            LAUNDER();
            pg8::SchedPlain S; S.o.init(M / 256, DM / 256, G, bid); S.A = (const char*)(ws + WS_MERGED); S.B = (const char*)(ws + WS_WOUT); S.tstepA = (size_t)256 * DM * 2; S.tstepB = (size_t)256 * DM * 2; S.nt = DM / 64;
            pg8::EpiBf16 E{(bf16_t*)(ws + WS_F_MIX), DM};
            pg8::gemm_phase<false, GSP2, GALIGN>(lds, DM, DM, S, E);
            GRID_BAR();
        }
        if (IN(10)) {
            LAUNDER();
            resnorm_rows((const bf16_t*)(ws + WS_F_MIX), XN, RSTD, nullptr, 1.0f, a.mix_norm + (size_t)(l * 2 + 1) * DM, gw, NGW, lane);
            GRID_BAR();
        }
        if (IN(11)) for (int rep_ = 0; rep_ < (((RPT_MASK >> 11) & 1) ? 2 : 1); ++rep_) {
            LAUNDER();
            pg8::SchedPlain S; S.o.init(M / 256, 2 * DFF / 256, G, bid, COLCH); S.A = (const char*)XN; S.B = (const char*)(ws + WS_W13B); S.tstepA = (size_t)256 * DM * 2; S.tstepB = (size_t)256 * DM * 2; S.nt = DM / 64;
            pg8::EpiSwiglu E{(bf16_t*)(ws + WS_ACT), DFF};
            pg8::gemm_phase<false, GSP2, GALIGN>(lds, DM, DM, S, E);
            GRID_BAR();
        }
        if (IN(12)) for (int rep_ = 0; rep_ < (((RPT_MASK >> 12) & 1) ? 2 : 1); ++rep_) {
            LAUNDER();
            pg8::SchedPlain S; S.o.init(M / 256, DM / 256, G, bid, 1); S.A = (const char*)(ws + WS_ACT); S.B = (const char*)(ws + WS_W2B); S.tstepA = (size_t)256 * DFF * 2; S.tstepB = (size_t)256 * DFF * 2; S.nt = DFF / 64;
            pg8::EpiBf16 E{(bf16_t*)(ws + WS_F_FFN), DM};
            pg8::gemm_phase<false, GSP2, GALIGN>(lds, DFF, DFF, S, E);
            GRID_BAR();
        }
        if (IN(13)) {
            LAUNDER();
            const bool lastl = (l + 1 == DEPTH);
            resnorm_rows((const bf16_t*)(ws + WS_F_FFN), XN, RSTD, lastl ? a.out : nullptr, 0.5f, a.ffn2_norm + (size_t)(l * 2 + 1) * DM, gw, NGW, lane);
            if (!lastl) { __syncthreads(); convert_weights(a, l + 1, lds, bid, G, lane, wave); GRID_BAR(); }
        }
#undef IN
    }
}

extern "C" void kernel_launch(void* const* d_in, const int* in_sizes, int n_in, void* d_out, int out_size, void* d_ws, size_t ws_size, hipStream_t stream) {
    static int grid = 0;
    if (grid == 0) {
        if (n_in != 15 || in_sizes[0] != M * DM || out_size != M * DM || ws_size < WS_END) { fprintf(stderr, "kernel_launch: unexpected shapes (n_in %d, in0 %d, out %d, ws %zu < %zu)\n", n_in, n_in > 0 ? in_sizes[0] : -1, out_size, ws_size, (size_t)WS_END); grid = -1; return; }
        int dev = 0, cus = 0, per_cu = 0;
        if (hipGetDevice(&dev) != hipSuccess || hipDeviceGetAttribute(&cus, hipDeviceAttributeMultiprocessorCount, dev) != hipSuccess) { grid = -1; return; }
        if (hipFuncSetAttribute((const void*)fwd_kernel, hipFuncAttributeMaxDynamicSharedMemorySize, LDS_BYTES) != hipSuccess) { fprintf(stderr, "kernel_launch: hipFuncSetAttribute failed\n"); grid = -1; return; }
        if (hipOccupancyMaxActiveBlocksPerMultiprocessor(&per_cu, (const void*)fwd_kernel, 512, LDS_BYTES) != hipSuccess || per_cu < 1) fprintf(stderr, "kernel_launch: occupancy query reports %d\n", per_cu);
        (void)hipGetLastError();
        grid = cus;
    }
    if (grid < 0) return;
    if (hipMemsetAsync((char*)d_ws + WS_CTL, 0, 1 * MiB, stream) != hipSuccess) return;
    Args a{};
    a.x = (const float*)d_in[0]; a.ffn1_norm = (const float*)d_in[1]; a.ffn1_w13 = (const float*)d_in[2]; a.ffn1_w2 = (const float*)d_in[3]; a.mix_norm = (const float*)d_in[4]; a.w_in = (const float*)d_in[5];
    a.lb_logits = (const float*)d_in[6]; a.hgrn_norm = (const float*)d_in[7]; a.sinks = (const float*)d_in[8]; a.w_branch = (const float*)d_in[9]; a.w_out = (const float*)d_in[10];
    a.ffn2_norm = (const float*)d_in[11]; a.ffn2_w13 = (const float*)d_in[12]; a.ffn2_w2 = (const float*)d_in[13]; a.rel_bias = (const float*)d_in[14];
    a.out = (float*)d_out; a.ws = (unsigned char*)d_ws;
#if MK_ONE_LAUNCH
    a.l_lo = 0; a.l_hi = DEPTH; a.ph_lo = 0; a.ph_hi = NPH;
    hipLaunchKernelGGL(fwd_kernel, dim3(grid), dim3(512), LDS_BYTES, stream, a);
#else
    for (int l = 0; l < DEPTH; ++l)
        for (int p = (l == 0 ? 0 : 1); p < NPH; ++p) { a.l_lo = l; a.l_hi = l + 1; a.ph_lo = p; a.ph_hi = p + 1; hipLaunchKernelGGL(fwd_kernel, dim3(grid), dim3(512), LDS_BYTES, stream, a); }
#endif
}
```

```cpp
#include <hip/hip_runtime.h>
#include <cstdio>

#ifndef MK_ONE_LAUNCH
#define MK_ONE_LAUNCH 1
#endif
#ifndef COLCH
#define COLCH 2
#endif
#ifndef F8MASK
#define F8MASK 15
#endif
#ifndef GSP2
#define GSP2 true
#endif
#ifndef GALIGN
#define GALIGN true
#endif
#ifndef RPT_MASK
#define RPT_MASK 0
#endif
#ifndef PHMASK
#define PHMASK 0x3fff
#endif

#define LAS __attribute__((address_space(3)))
typedef unsigned short bf16_t;
typedef short bf16x8 __attribute__((ext_vector_type(8)));
typedef float f32x4 __attribute__((ext_vector_type(4)));
typedef unsigned u32x4 __attribute__((ext_vector_type(4)));
typedef unsigned u32x2 __attribute__((ext_vector_type(2)));

constexpr int DM = 2048, NBATCH = 8, SEQ = 4096, DEPTH = 4, M = NBATCH * SEQ;
constexpr int DFF = 5632, NIN = 14848, MIXIN = 6656, BRT = 1792, NGATE = 8192;
constexpr float EPS = 1e-6f;
constexpr int AQ = 0, AF = 512, AI = 1024, AG = 1536, BQ = 2048, BKo = 2560, BVo = 3072, CQ = 3584, CKo = 4352, CVo = 5120, DQo = 5888, DKo = 6400, DVo = 6528;
constexpr int NCHUNK = M / 64;

constexpr size_t MiB = 1u << 20;
constexpr size_t WS_CTL = 0;
constexpr size_t WS_W13A = 1 * MiB;
constexpr size_t WS_W2A = WS_W13A + 44 * MiB;
constexpr size_t WS_WIN = WS_W2A + 22 * MiB;
constexpr size_t WS_WBR = WS_WIN + 58 * MiB;
constexpr size_t WS_WOUT = WS_WBR + 7 * MiB;
constexpr size_t WS_W13B = WS_WOUT + 8 * MiB;
constexpr size_t WS_W2B = WS_W13B + 44 * MiB;
constexpr size_t WS_WG8 = WS_W2B + 22 * MiB;
constexpr size_t WS_XN = WS_WG8 + 16 * MiB;
constexpr size_t WS_H16 = WS_XN + 128 * MiB;
constexpr size_t WS_R = WS_H16 + 128 * MiB;
constexpr size_t WS_ACT = WS_R;
constexpr size_t WS_F_FFN = WS_R + 352 * MiB;
constexpr size_t WS_PROJ = WS_R;
constexpr size_t WS_GATES = WS_R + 416 * MiB;
constexpr size_t WS_YALL = WS_GATES + 512 * MiB;
constexpr size_t WS_QI = WS_YALL + 112 * MiB;
constexpr size_t WS_OINTRA = WS_QI + 32 * MiB;
constexpr size_t WS_SPREV = WS_OINTRA + 64 * MiB;
constexpr size_t WS_DC = WS_SPREV + 64 * MiB;
constexpr size_t WS_CPART = WS_DC + 1 * MiB;
constexpr size_t WS_CLSE = WS_CPART + 48 * MiB;
constexpr size_t WS_END = WS_CLSE + 2 * MiB;
constexpr size_t WS_U = WS_XN;
constexpr size_t WS_MERGED = WS_PROJ;
constexpr size_t WS_F_MIX = WS_GATES;
constexpr size_t WS_XN8 = WS_XN;
constexpr float GATE_WSCALE = 32.0f;
constexpr int CW_BAR = 4096;

typedef _Float16 h16x2 __attribute__((ext_vector_type(2)));
typedef _Float16 h16x8 __attribute__((ext_vector_type(8)));
__device__ __forceinline__ unsigned cvt_pk_bf16(float lo, float hi) { h16x2 v; v.x = (_Float16)lo; v.y = (_Float16)hi; return __builtin_bit_cast(unsigned, v); }
__device__ __forceinline__ bf16_t f2bf(float f) { return __builtin_bit_cast(unsigned short, (_Float16)f); }
__device__ __forceinline__ float bf2f(bf16_t b) { return (float)__builtin_bit_cast(_Float16, b); }
__device__ __forceinline__ float bflo(unsigned w) { return (float)__builtin_bit_cast(h16x2, w).x; }
__device__ __forceinline__ float bfhi(unsigned w) { return (float)__builtin_bit_cast(h16x2, w).y; }
#define MFMA16(a, b, c) __builtin_amdgcn_mfma_f32_16x16x32_f16(__builtin_bit_cast(h16x8, (a)), __builtin_bit_cast(h16x8, (b)), (c), 0, 0, 0)
__device__ __forceinline__ unsigned cvt_pk_b16(float lo, float hi) { unsigned r; asm volatile("v_cvt_pk_bf16_f32 %0, %1, %2" : "=v"(r) : "v"(lo), "v"(hi)); return r; }
__device__ __forceinline__ bf16_t f2b16(float f) { return (bf16_t)(cvt_pk_b16(f, 0.f) & 0xffffu); }
__device__ __forceinline__ float b16lo(unsigned w) { return __uint_as_float(w << 16); }
__device__ __forceinline__ float b16hi(unsigned w) { return __uint_as_float(w & 0xffff0000u); }
#define MFMAB(a, b, c) __builtin_amdgcn_mfma_f32_16x16x32_bf16((a), (b), (c), 0, 0, 0)
typedef int v8i32 __attribute__((ext_vector_type(8)));
typedef int v4i32 __attribute__((ext_vector_type(4)));
__device__ __forceinline__ unsigned pk_fp8x4(float a, float b, float c, float d) { int w = __builtin_amdgcn_cvt_pk_fp8_f32(a, b, 0, false); w = __builtin_amdgcn_cvt_pk_fp8_f32(c, d, w, true); return (unsigned)w; }
__device__ __forceinline__ f32x4 mfma_fp8(const bf16x8 a0, const bf16x8 a1, const bf16x8 b0, const bf16x8 b1, const f32x4 c) {
    const u32x4 x0 = __builtin_bit_cast(u32x4, a0), x1 = __builtin_bit_cast(u32x4, a1), y0 = __builtin_bit_cast(u32x4, b0), y1 = __builtin_bit_cast(u32x4, b1);
    const v8i32 A = {(int)x0.x, (int)x0.y, (int)x0.z, (int)x0.w, (int)x1.x, (int)x1.y, (int)x1.z, (int)x1.w}, B = {(int)y0.x, (int)y0.y, (int)y0.z, (int)y0.w, (int)y1.x, (int)y1.y, (int)y1.z, (int)y1.w};
    return __builtin_amdgcn_mfma_scale_f32_16x16x128_f8f6f4(A, B, c, 0, 0, 0, 0x7f7f7f7f, 0, 0x7f7f7f7f);
}
__device__ __forceinline__ float wave_sum(float v) {
#pragma unroll
    for (int o = 1; o < 64; o <<= 1) v += __shfl_xor(v, o);
    return v;
}
__device__ __forceinline__ float fast_sigmoid(float x) { return __builtin_amdgcn_rcpf(1.0f + __expf(-x)); }
#define LDS_WAIT() asm volatile("s_waitcnt lgkmcnt(0)" ::: "memory")
template <int CTRL> __device__ __forceinline__ float dpp_f(float x) { return __builtin_bit_cast(float, __builtin_amdgcn_update_dpp(0, __builtin_bit_cast(int, x), CTRL, 0xf, 0xf, true)); }
__device__ __forceinline__ float row16_max(float v) { v = fmaxf(v, dpp_f<0xB1>(v)); v = fmaxf(v, dpp_f<0x4E>(v)); v = fmaxf(v, dpp_f<0x141>(v)); v = fmaxf(v, dpp_f<0x140>(v)); return v; }
__device__ __forceinline__ float row16_sum(float v) { v += dpp_f<0xB1>(v); v += dpp_f<0x4E>(v); v += dpp_f<0x141>(v); v += dpp_f<0x140>(v); return v; }

template <int TOFF> __device__ __forceinline__ void tr_frag4(unsigned addr, bf16x8 (&v)[4]) {
    u32x2 a0, a1, b0, b1, c0, c1, d0, d1;
    asm volatile("ds_read_b64_tr_b16 %0, %8\n\tds_read_b64_tr_b16 %1, %8 offset:%9\n\tds_read_b64_tr_b16 %2, %8 offset:32\n\tds_read_b64_tr_b16 %3, %8 offset:%10\n\t"
                 "ds_read_b64_tr_b16 %4, %8 offset:64\n\tds_read_b64_tr_b16 %5, %8 offset:%11\n\tds_read_b64_tr_b16 %6, %8 offset:96\n\tds_read_b64_tr_b16 %7, %8 offset:%12\n\ts_waitcnt lgkmcnt(0)"
                 : "=&v"(a0), "=&v"(a1), "=&v"(b0), "=&v"(b1), "=&v"(c0), "=&v"(c1), "=&v"(d0), "=&v"(d1) : "v"(addr), "n"(TOFF), "n"(TOFF + 32), "n"(TOFF + 64), "n"(TOFF + 96) : "memory");
    v[0] = __builtin_bit_cast(bf16x8, (u32x4){a0.x, a0.y, a1.x, a1.y}); v[1] = __builtin_bit_cast(bf16x8, (u32x4){b0.x, b0.y, b1.x, b1.y});
    v[2] = __builtin_bit_cast(bf16x8, (u32x4){c0.x, c0.y, c1.x, c1.y}); v[3] = __builtin_bit_cast(bf16x8, (u32x4){d0.x, d0.y, d1.x, d1.y});
}
__device__ __forceinline__ unsigned lds_addr(const LAS void* p) { return (unsigned)(size_t)p; }

#define XB_TMO      128
#define XB_XCNT(j)  (256  + 64 * (j))
#define XB_XSUB(j)  (1280 + 64 * (j))
#define XB_XGEN(j)  (2304 + 64 * (j))
#define XB_TOP      3328
#define XB_TOPGEN   3392
#define XCD_BAR_WORDS 3456
#define XB_SPIN_CAP (1u << 18)

__device__ __forceinline__ unsigned xb_ld(unsigned* p)              { return __hip_atomic_load(p, __ATOMIC_RELAXED, __HIP_MEMORY_SCOPE_AGENT); }
__device__ __forceinline__ unsigned xb_add(unsigned* p, unsigned v) { return __hip_atomic_fetch_add(p, v, __ATOMIC_RELAXED, __HIP_MEMORY_SCOPE_AGENT); }
__device__ __forceinline__ unsigned xb_xcc_id() { return (unsigned)__builtin_amdgcn_s_getreg((3 << 11) | 20) & 0xFu; }
#define XB_SPIN(cond, bar) do { unsigned _sp = 0; while (cond) { __builtin_amdgcn_s_sleep(1); \
    if ((++_sp & 255u) == 0u) { if (xb_ld(&(bar)[XB_TMO])) break; if (_sp > XB_SPIN_CAP) { atomicAdd(&(bar)[XB_TMO], 1u); break; } } } } while (0)

struct XcdBarrier { unsigned* bar; unsigned x; volatile LAS unsigned* st; };

__device__ __forceinline__ XcdBarrier xcd_barrier_post(unsigned* bar, volatile LAS unsigned* st) {
    XcdBarrier b; b.bar = bar; b.x = xb_xcc_id(); b.st = st;
    if (threadIdx.x == 0) (void)xb_add(&bar[XB_XCNT(b.x)], 1u);
    return b;
}
__device__ __forceinline__ void xcd_barrier_complete(unsigned* bar, unsigned x, unsigned& nloc, unsigned& nx) {
    const unsigned G = gridDim.x * gridDim.y * gridDim.z;
    unsigned sum, cnt, mine, sp = 0u;
    for (;;) {
        sum = 0u; cnt = 0u; mine = 0u;
#pragma unroll
        for (unsigned j = 0; j < 16; ++j) { const unsigned c = xb_ld(&bar[XB_XCNT(j)]); sum += c; cnt += (c > 0u) ? 1u : 0u; mine = (j == x) ? c : mine; }
        if (sum == G) break;
        __builtin_amdgcn_s_sleep(1);
        if ((++sp & 255u) == 0u) { if (xb_ld(&bar[XB_TMO])) break; if (sp > XB_SPIN_CAP) { atomicAdd(&bar[XB_TMO], 1u); break; } }
    }
    nloc = mine > 0u ? mine : 1u; nx = cnt > 0u ? cnt : 1u;
}
__device__ __forceinline__ void xcd_barrier(const XcdBarrier& b) {
    asm volatile("s_waitcnt vmcnt(0)" ::: "memory");
    __syncthreads();
    if (threadIdx.x == 0) {
        unsigned* bar = b.bar;
        __builtin_amdgcn_s_waitcnt(0);
        unsigned nloc = b.st[0], nx = b.st[1];
        if (nloc == 0u) { xcd_barrier_complete(bar, b.x, nloc, nx); b.st[0] = nloc; b.st[1] = nx; }
        const unsigned old = xb_add(&bar[XB_XSUB(b.x)], 1u);
        const unsigned gen = old / nloc;
        if (old + 1u == (gen + 1u) * nloc) {
            __builtin_amdgcn_fence(__ATOMIC_RELEASE, "agent");
            asm volatile("s_waitcnt vmcnt(0)" ::: "memory");
            const unsigned og = xb_add(&bar[XB_TOP], 1u);
            const unsigned tg = og / nx;
            if (og + 1u == (tg + 1u) * nx) xb_add(&bar[XB_TOPGEN], 1u);
            else XB_SPIN(xb_ld(&bar[XB_TOPGEN]) == tg, bar);
            xb_add(&bar[XB_XGEN(b.x)], 1u);
            __builtin_amdgcn_fence(__ATOMIC_ACQUIRE, "agent");
            asm volatile("s_waitcnt vmcnt(0)" ::: "memory");
        } else {
            XB_SPIN(xb_ld(&bar[XB_XGEN(b.x)]) == gen, bar);
            __builtin_amdgcn_fence(__ATOMIC_ACQUIRE, "agent");
            asm volatile("s_waitcnt vmcnt(0)" ::: "memory");
        }
    }
    __syncthreads();
}

namespace pg8 {
constexpr int BM = 256, BK = 64, HALF = 128, HTB = HALF * BK * 2, STAGE_BYTES = 8 * HTB, NXCD = 8, WGM = 4;
__device__ __forceinline__ int lds_byte(int r, int c) { const int st = (r >> 4) * 2 + (c >> 5), rr = r & 15, cc = c & 31, ob = rr * 64 + cc * 2; return st * 1024 + (ob ^ (((ob >> 9) & 1) << 5)); }
__device__ __forceinline__ void stage_rc(int b, int& R, int& C) { const int st = b / 1024, sb = b % 1024, swz = sb ^ (((sb >> 9) & 1) << 5); R = (st >> 1) * 16 + swz / 64; C = (st & 1) * 32 + (swz % 64) / 2; }
__device__ __forceinline__ int perm32(int rho) { const int n = rho >> 4, i = rho & 15; return 8 * (i >> 2) + 4 * n + (i & 3); }

struct Unit { int pm, pn, aux, nt; const char* A; const char* B; };

struct TileOrder {
    int nM, nN, nwg, G, c, rev;
    __device__ __forceinline__ void init(int nM_, int nN_, int G_, int c_, int rev_ = 0) { nM = nM_; nN = nN_; nwg = nM * nN; G = G_; c = c_; rev = rev_; }
    __device__ __forceinline__ bool tile(int i, int& pm, int& pn) const {
        const long L = (long)i * G + c; if (L >= nwg) return false;
        int wgid = (int)L; { const int q = nwg / NXCD, r = nwg % NXCD, xcd = wgid % NXCD; int off = wgid / NXCD; if ((rev & 1) && r == 0) off = q - 1 - off;
            wgid = (xcd < r ? xcd * (q + 1) : r * (q + 1) + (xcd - r) * q) + off; }
        if (rev & 2) {
            const int nig = WGM * nM, gid = wgid / nig, fn = gid * WGM, gsz = (nN - fn) < WGM ? (nN - fn) : WGM;
            pn = fn + ((wgid % nig) % gsz); pm = (wgid % nig) / gsz; return true; }
        const int nig = WGM * nN, gid = wgid / nig, fm = gid * WGM, gsz = (nM - fm) < WGM ? (nM - fm) : WGM;
        pm = fm + ((wgid % nig) % gsz); pn = (wgid % nig) / gsz; return true;
    }
};
struct SchedPlain {
    TileOrder o; const char* A; const char* B; size_t tstepA, tstepB; int nt; int bmap = -1;
    __device__ __forceinline__ bool next(int i, Unit& u) const {
        if (!o.tile(i, u.pm, u.pn)) return false;
        if (bmap >= 0) u.pn = 8 * ((bmap >> (4 * (u.pn >> 3))) & 15) + (u.pn & 7);
        u.A = A + (size_t)u.pm * tstepA; u.B = B + (size_t)u.pn * tstepB; u.nt = nt; u.aux = 0; return true;
    }
};
struct SchedBranch {
    TileOrder o; const char* A; const char* B; size_t tstepA, tstepB;
    __device__ __forceinline__ bool next(int i, Unit& u) const {
        if (!o.tile(i >> 2, u.pm, u.pn)) return false;
        const int br = i & 3; const int koff = br == 0 ? 0 : (br == 1 ? 512 : (br == 2 ? 1024 : 1280));
        u.A = A + (size_t)u.pm * tstepA + (size_t)koff * 2; u.B = B + (size_t)u.pn * tstepB + (size_t)koff * 2; u.nt = (br == 2) ? 4 : 8; u.aux = br; return true;
    }
};

struct EpiBf16 {
    bf16_t* O; int ldc;
    __device__ __forceinline__ bool operator()(f32x4 (&acc)[2][2][4][2], const Unit& u, int wr, int wc, int fr, int fq) const {
        const int row0 = u.pm * BM + wr * 64 + fr, col0 = u.pn * BM + wc * 32 + 8 * fq;
#pragma unroll
        for (int ai = 0; ai < 2; ++ai)
#pragma unroll
            for (int m = 0; m < 4; ++m) { bf16_t* rowp = O + (size_t)(row0 + ai * HALF + m * 16) * ldc + col0;
#pragma unroll
                for (int bj = 0; bj < 2; ++bj) { const f32x4 v0 = acc[ai][bj][m][0], v1 = acc[ai][bj][m][1];
                    u32x4 w; w.x = cvt_pk_bf16(v0[0], v0[1]); w.y = cvt_pk_bf16(v0[2], v0[3]); w.z = cvt_pk_bf16(v1[0], v1[1]); w.w = cvt_pk_bf16(v1[2], v1[3]);
                    *(u32x4*)(rowp + bj * HALF) = w; } }
        return true;
    }
};
struct EpiSwiglu {
    bf16_t* O; int ldc;
    __device__ __forceinline__ bool operator()(f32x4 (&acc)[2][2][4][2], const Unit& u, int wr, int wc, int fr, int fq) const {
        typedef float f32x2 __attribute__((ext_vector_type(2)));
        const int row0 = u.pm * BM + wr * 64 + fr, col0 = u.pn * HALF + wc * 32 + 8 * fq;
#pragma unroll
        for (int ai = 0; ai < 2; ++ai)
#pragma unroll
            for (int m = 0; m < 4; ++m) { bf16_t* rowp = O + (size_t)(row0 + ai * HALF + m * 16) * ldc + col0;
                unsigned w[4];
#pragma unroll
                for (int n = 0; n < 2; ++n)
#pragma unroll
                    for (int jp = 0; jp < 2; ++jp) { const f32x2 g = {acc[ai][0][m][n][2 * jp], acc[ai][0][m][n][2 * jp + 1]}, up = {acc[ai][1][m][n][2 * jp], acc[ai][1][m][n][2 * jp + 1]};
                        f32x2 e; e.x = __builtin_amdgcn_exp2f(g.x); e.y = __builtin_amdgcn_exp2f(g.y);
                        const f32x2 d = e + 1.0f; f32x2 r; r.x = __builtin_amdgcn_rcpf(d.x); r.y = __builtin_amdgcn_rcpf(d.y);
                        const f32x2 h = (g * up) * r; w[n * 2 + jp] = cvt_pk_b16(h.x, h.y); }
                *(u32x4*)rowp = (u32x4){w[0], w[1], w[2], w[3]}; }
        return true;
    }
};
struct EpiInproj {
    bf16_t* P; bf16_t* Gt;
    __device__ __forceinline__ bool operator()(f32x4 (&acc)[2][2][4][2], const Unit& u, int wr, int wc, int fr, int fq) const {
        const int row0 = u.pm * BM + wr * 64 + fr; const bool isg = u.pn >= 26;
        bf16_t* base = isg ? Gt : P; const int ldc = isg ? NGATE : MIXIN; const int col0 = (isg ? (u.pn - 26) : u.pn) * BM + wc * 32 + 8 * fq;
#pragma unroll
        for (int ai = 0; ai < 2; ++ai)
#pragma unroll
            for (int m = 0; m < 4; ++m) { bf16_t* rowp = base + (size_t)(row0 + ai * HALF + m * 16) * ldc + col0;
#pragma unroll
                for (int bj = 0; bj < 2; ++bj) { f32x4 v0 = acc[ai][bj][m][0], v1 = acc[ai][bj][m][1];
                    if (isg) {
#pragma unroll
                        for (int j = 0; j < 4; ++j) { v0[j] = fminf(1.0f + __expf(-v0[j]), 60000.0f); v1[j] = fminf(1.0f + __expf(-v1[j]), 60000.0f); } }
                    u32x4 w; w.x = cvt_pk_bf16(v0[0], v0[1]); w.y = cvt_pk_bf16(v0[2], v0[3]); w.z = cvt_pk_bf16(v1[0], v1[1]); w.w = cvt_pk_bf16(v1[2], v1[3]);
                    *(u32x4*)(rowp + bj * HALF) = w; } }
        return true;
    }
};
struct EpiGates {
    unsigned char* Gt; float inv;
    __device__ __forceinline__ bool operator()(f32x4 (&acc)[2][2][4][2], const Unit& u, int wr, int wc, int fr, int fq) const {
        const int row0 = u.pm * BM + wr * 64 + fr, col0 = u.pn * BM + wc * 32 + 8 * fq; const float ninv2 = -inv * 1.44269504089f;
#pragma unroll
        for (int ai = 0; ai < 2; ++ai)
#pragma unroll
            for (int m = 0; m < 4; ++m) { unsigned char* rowp = Gt + (size_t)(row0 + ai * HALF + m * 16) * NGATE + col0;
#pragma unroll
                for (int bj = 0; bj < 2; ++bj) { const f32x4 v0 = acc[ai][bj][m][0] * ninv2, v1 = acc[ai][bj][m][1] * ninv2;
                    f32x4 e0, e1;
#pragma unroll
                    for (int j = 0; j < 4; ++j) { e0[j] = fminf(__builtin_amdgcn_exp2f(v0[j]), 500.0f); e1[j] = fminf(__builtin_amdgcn_exp2f(v1[j]), 500.0f); }
                    e0 = e0 + 1.0f; e1 = e1 + 1.0f;
                    f32x4 g0, g1;
#pragma unroll
                    for (int j = 0; j < 4; ++j) { g0[j] = __builtin_amdgcn_rcpf(e0[j]); g1[j] = __builtin_amdgcn_rcpf(e1[j]); }
                    g0 = g0 * 255.0f; g1 = g1 * 255.0f;
                    unsigned w0 = 0u, w1 = 0u;
#pragma unroll
                    for (int j = 0; j < 4; ++j) { w0 = __builtin_amdgcn_cvt_pk_u8_f32(__builtin_rintf(g0[j]), j, w0); w1 = __builtin_amdgcn_cvt_pk_u8_f32(__builtin_rintf(g1[j]), j, w1); }
                    *(u32x2*)(rowp + bj * HALF) = (u32x2){w0, w1}; } }
        return true;
    }
};
struct EpiBranch {
    bf16_t* Mg; const unsigned char* Gt;
    __device__ __forceinline__ void apply(f32x4 (&acc)[2][2][4][2], int ai, int m, int bj, const u32x2 c8, const u32x2 n8, int br, size_t off) const {
        f32x4 v0 = acc[ai][bj][m][0], v1 = acc[ai][bj][m][1];
#define UB(w, k) ((float)(((w) >> (8 * (k))) & 0xffu))
        v0[0] *= UB(c8.x, 0) * __builtin_amdgcn_rcpf(UB(n8.x, 0)); v0[1] *= UB(c8.x, 1) * __builtin_amdgcn_rcpf(UB(n8.x, 1));
        v0[2] *= UB(c8.x, 2) * __builtin_amdgcn_rcpf(UB(n8.x, 2)); v0[3] *= UB(c8.x, 3) * __builtin_amdgcn_rcpf(UB(n8.x, 3));
        v1[0] *= UB(c8.y, 0) * __builtin_amdgcn_rcpf(UB(n8.y, 0)); v1[1] *= UB(c8.y, 1) * __builtin_amdgcn_rcpf(UB(n8.y, 1));
        v1[2] *= UB(c8.y, 2) * __builtin_amdgcn_rcpf(UB(n8.y, 2)); v1[3] *= UB(c8.y, 3) * __builtin_amdgcn_rcpf(UB(n8.y, 3));
#undef UB
        if (br < 3) { acc[ai][bj][m][0] = v0; acc[ai][bj][m][1] = v1; }
        else { u32x4 w; w.x = cvt_pk_b16(v0[0], v0[1]); w.y = cvt_pk_b16(v0[2], v0[3]); w.z = cvt_pk_b16(v1[0], v1[1]); w.w = cvt_pk_b16(v1[2], v1[3]); *(u32x4*)(Mg + off) = w; }
    }
    __device__ __forceinline__ bool operator()(f32x4 (&acc)[2][2][4][2], const Unit& u, int wr, int wc, int fr, int fq) const {
        const int row0 = u.pm * BM + wr * 64 + fr, col0 = u.pn * BM + wc * 32 + 8 * fq; const int br = u.aux;
        const u32x2 one = (u32x2){0xffffffffu, 0xffffffffu};
        u32x2 ec[3][2], en[3][2];
#define EB_LOAD(buf, q) do { _Pragma("unroll") for (int bj = 0; bj < 2; ++bj) { \
            const unsigned char* gp = Gt + (size_t)(row0 + ((q) >> 2) * HALF + ((q) & 3) * 16) * NGATE + (size_t)br * DM + col0 + bj * HALF; \
            ec[buf][bj] = *(const u32x2*)gp; en[buf][bj] = one; if (br < 3) en[buf][bj] = *(const u32x2*)(gp + DM); } } while (0)
#define EB_APPLY(buf, q) do { _Pragma("unroll") for (int bj = 0; bj < 2; ++bj) \
            apply(acc, (q) >> 2, (q) & 3, bj, ec[buf][bj], en[buf][bj], br, (size_t)(row0 + ((q) >> 2) * HALF + ((q) & 3) * 16) * DM + col0 + bj * HALF); } while (0)
        EB_LOAD(0, 0); asm volatile("" ::: "memory");
        EB_LOAD(1, 1); asm volatile("" ::: "memory");
        EB_LOAD(2, 2); asm volatile("" ::: "memory");
        EB_APPLY(0, 0); asm volatile("" ::: "memory"); EB_LOAD(0, 3); asm volatile("" ::: "memory");
        EB_APPLY(1, 1); asm volatile("" ::: "memory"); EB_LOAD(1, 4); asm volatile("" ::: "memory");
        EB_APPLY(2, 2); asm volatile("" ::: "memory"); EB_LOAD(2, 5); asm volatile("" ::: "memory");
        EB_APPLY(0, 3); asm volatile("" ::: "memory"); EB_LOAD(0, 6); asm volatile("" ::: "memory");
        EB_APPLY(1, 4); asm volatile("" ::: "memory"); EB_LOAD(1, 7); asm volatile("" ::: "memory");
        EB_APPLY(2, 5); asm volatile("" ::: "memory");
        EB_APPLY(0, 6); asm volatile("" ::: "memory");
        EB_APPLY(1, 7); asm volatile("" ::: "memory");
#undef EB_LOAD
#undef EB_APPLY
        return br == 3;
    }
};

template <bool F8 = false, bool SP2 = false, bool ALIGN = false, class Epi, class Sched>
__device__ __forceinline__ void gemm_phase(LAS unsigned char* lds, const int lda, const int ldb, const Sched& S, const Epi& E) {
    int tid_ = threadIdx.x; asm volatile("" : "+v"(tid_));
    const int tid = tid_, wid = __builtin_amdgcn_readfirstlane(tid >> 6), lane = tid & 63, wr = wid >> 2, wc = wid & 3, fr = lane & 15, fq = lane >> 4;
    unsigned voffA[2], voffB[2];
#pragma unroll
    for (int i = 0; i < 2; ++i) { int R, C; stage_rc(tid * 16 + i * 8192, R, C); const int Rb = (R & ~31) + perm32(R & 31);
        voffA[i] = (unsigned)(R * lda + C) * 2u; voffB[i] = (unsigned)(Rb * ldb + C) * 2u; }
    const size_t kstep = (size_t)(BK * 2);
    const size_t hstepA = (size_t)HALF * lda * 2, hstepB = (size_t)HALF * ldb * 2;
    const unsigned ldsw = (unsigned)wid * 1024u;
    const int aoff = lds_byte(wr * 64 + fr, fq * 8), boff = lds_byte(wc * 32 + fr, fq * 8);
#define PG8_SA(b, h) (((b) * 2 + (h)) * HTB)
#define PG8_SB(b, h) ((4 + (b) * 2 + (h)) * HTB)
#define PG8_STAGE(bufoff, gbase, voff) do { _Pragma("unroll") for (int _i = 0; _i < 2; ++_i) \
        __builtin_amdgcn_global_load_lds((const unsigned*)((const char*)(gbase) + (voff)[_i]), (LAS unsigned*)(lds + (bufoff) + ldsw + _i * 8192), 16, 0, 0); } while (0)
#define PG8_LDA(dst, b, h) do { if constexpr (F8) { _Pragma("unroll") for (int m = 0; m < 4; ++m) { A8[m].lo = *(const LAS v4i32*)(lds + PG8_SA(b, h) + aoff + m * 2048); A8[m].hi = *(const LAS v4i32*)(lds + PG8_SA(b, h) + aoff + m * 2048 + 1024); } } \
        else { _Pragma("unroll") for (int m = 0; m < 4; ++m) _Pragma("unroll") for (int k = 0; k < 2; ++k) dst[m][k] = *(const LAS bf16x8*)(lds + PG8_SA(b, h) + aoff + m * 2048 + k * 1024); } } while (0)
#define PG8_LDB(dst, b, h) do { if constexpr (F8) { _Pragma("unroll") for (int n = 0; n < 2; ++n) { dst##8[n].lo = *(const LAS v4i32*)(lds + PG8_SB(b, h) + boff + n * 2048); dst##8[n].hi = *(const LAS v4i32*)(lds + PG8_SB(b, h) + boff + n * 2048 + 1024); } } \
        else { _Pragma("unroll") for (int n = 0; n < 2; ++n) _Pragma("unroll") for (int k = 0; k < 2; ++k) dst[n][k] = *(const LAS bf16x8*)(lds + PG8_SB(b, h) + boff + n * 2048 + k * 1024); } } while (0)
#define PG8_MMA(ai, bj, At, Bt) do { __builtin_amdgcn_s_setprio(1); _Pragma("unroll") for (int m = 0; m < 4; ++m) _Pragma("unroll") for (int n = 0; n < 2; ++n) { \
        if constexpr (F8) asm volatile("v_mfma_scale_f32_16x16x128_f8f6f4 %0, %1, %2, %0, %3, %3 op_sel_hi:[0,0,0]" : "+v"(acc[ai][bj][m][n]) : "v"(Bt##8[n]), "v"(A8[m]), "v"(sc8)); \
        else { _Pragma("unroll") for (int k = 0; k < 2; ++k) acc[ai][bj][m][n] = MFMAB(Bt[n][k], At[m][k], acc[ai][bj][m][n]); } } __builtin_amdgcn_s_setprio(0); } while (0)
#define PG8_WAIT_V(n) asm volatile("s_waitcnt vmcnt(" #n ")" ::: "memory")
#define PG8_WAIT_L(n) asm volatile("s_waitcnt lgkmcnt(" #n ")" ::: "memory")
#define PG8_BAR __builtin_amdgcn_s_barrier()
#define PG8_SCHED __builtin_amdgcn_sched_barrier(0)
    Unit cur, nxt; int ui = 0;
    if (!S.next(0, cur)) return;
    f32x4 acc[2][2][4][2];
#pragma unroll
    for (int a = 0; a < 2; ++a)
#pragma unroll
        for (int b = 0; b < 2; ++b)
#pragma unroll
            for (int m = 0; m < 4; ++m)
#pragma unroll
                for (int n = 0; n < 2; ++n) acc[a][b][m][n] = (f32x4){0.f, 0.f, 0.f, 0.f};
    bf16x8 At[4][2], B0[2][2], B1[2][2];
    v8i32 A8[4], B08[2], B18[2];
    const int sc8 = 0x7f7f7f7f;
    const char* cA = cur.A; const char* cB = cur.B; int nt = cur.nt;
    if constexpr (SP2) {
        PG8_STAGE(PG8_SB(0, 0), cB, voffB); PG8_STAGE(PG8_SB(0, 1), cB + hstepB, voffB); PG8_STAGE(PG8_SA(0, 0), cA, voffA); PG8_STAGE(PG8_SA(0, 1), cA + hstepA, voffA);
        if (wr == 1) PG8_BAR;
        PG8_WAIT_V(2); PG8_BAR;
        PG8_STAGE(PG8_SB(1, 0), cB + kstep, voffB); PG8_STAGE(PG8_SA(1, 0), cA + kstep, voffA); PG8_STAGE(PG8_SB(1, 1), cB + hstepB + kstep, voffB);
        PG8_WAIT_V(6); PG8_BAR;
    } else {
    PG8_STAGE(PG8_SB(0, 0), cB, voffB); PG8_STAGE(PG8_SA(0, 0), cA, voffA); PG8_STAGE(PG8_SB(0, 1), cB + hstepB, voffB); PG8_STAGE(PG8_SA(0, 1), cA + hstepA, voffA);
    if (wr == 1) PG8_BAR;
    PG8_WAIT_V(4); PG8_BAR;
    PG8_STAGE(PG8_SB(1, 0), cB + kstep, voffB); PG8_STAGE(PG8_SA(1, 0), cA + kstep, voffA); PG8_STAGE(PG8_SB(1, 1), cB + hstepB + kstep, voffB);
    PG8_WAIT_V(6); PG8_BAR;
    }
    for (;;) {
        const bool has_next = S.next(ui + 1, nxt);
        const char* nA = has_next ? nxt.A : cA; const char* nB = has_next ? nxt.B : cB;
        for (int t = 0; t < nt; t += 2) {
            const bool last = (t == nt - 2);
            const char* a1 = cA + (size_t)(t + 1) * kstep;
            const char* a2 = last ? nA : cA + (size_t)(t + 2) * kstep; const char* b2 = last ? nB : cB + (size_t)(t + 2) * kstep;
            const char* a3 = a2 + kstep; const char* b3 = b2 + kstep;
            if constexpr (SP2) {
            PG8_LDB(B0, 0, 0); PG8_LDB(B1, 0, 1); PG8_SCHED; PG8_LDA(At, 0, 0); PG8_STAGE(PG8_SA(1, 1), a1 + hstepA, voffA);
            PG8_WAIT_V(8); PG8_WAIT_L(0); PG8_BAR; PG8_MMA(0, 0, At, B0); PG8_MMA(0, 1, At, B1); PG8_BAR; PG8_SCHED;
            PG8_LDA(At, 0, 1); PG8_STAGE(PG8_SB(0, 0), b2, voffB); PG8_STAGE(PG8_SB(0, 1), b2 + hstepB, voffB); PG8_STAGE(PG8_SA(0, 0), a2, voffA);
            PG8_WAIT_V(8); PG8_WAIT_L(0); PG8_BAR; PG8_MMA(1, 0, At, B0); PG8_MMA(1, 1, At, B1); PG8_BAR; PG8_SCHED;
            PG8_LDB(B0, 1, 0); PG8_LDB(B1, 1, 1); PG8_SCHED; PG8_LDA(At, 1, 0); PG8_STAGE(PG8_SA(0, 1), a2 + hstepA, voffA);
            PG8_WAIT_V(8); PG8_WAIT_L(0); PG8_BAR; PG8_MMA(0, 0, At, B0); PG8_MMA(0, 1, At, B1); PG8_BAR; PG8_SCHED;
            PG8_LDA(At, 1, 1); PG8_STAGE(PG8_SB(1, 0), b3, voffB); PG8_STAGE(PG8_SB(1, 1), b3 + hstepB, voffB); PG8_STAGE(PG8_SA(1, 0), a3, voffA);
            PG8_WAIT_V(8); PG8_WAIT_L(0); PG8_BAR; PG8_MMA(1, 0, At, B0); PG8_MMA(1, 1, At, B1); PG8_BAR; PG8_SCHED;
            } else {
            PG8_LDB(B0, 0, 0); PG8_SCHED; PG8_LDA(At, 0, 0); PG8_STAGE(PG8_SA(1, 1), a1 + hstepA, voffA);
            PG8_WAIT_L(8); PG8_BAR; PG8_WAIT_L(0); PG8_MMA(0, 0, At, B0); PG8_BAR; PG8_SCHED;
            PG8_LDB(B1, 0, 1); PG8_STAGE(PG8_SB(0, 0), b2, voffB);
            PG8_BAR; PG8_WAIT_L(0); PG8_MMA(0, 1, At, B1); PG8_BAR;
            PG8_LDA(At, 0, 1); PG8_STAGE(PG8_SA(0, 0), a2, voffA);
            PG8_BAR; PG8_WAIT_L(0); PG8_MMA(1, 0, At, B0); PG8_BAR; PG8_SCHED;
            PG8_STAGE(PG8_SB(0, 1), b2 + hstepB, voffB);
            PG8_WAIT_V(6); PG8_BAR; PG8_MMA(1, 1, At, B1); PG8_BAR;
            PG8_LDB(B0, 1, 0); PG8_SCHED; PG8_LDA(At, 1, 0); PG8_STAGE(PG8_SA(0, 1), a2 + hstepA, voffA);
            PG8_WAIT_L(8); PG8_BAR; PG8_WAIT_L(0); PG8_MMA(0, 0, At, B0); PG8_BAR; PG8_SCHED;
            PG8_LDB(B1, 1, 1); PG8_STAGE(PG8_SB(1, 0), b3, voffB);
            PG8_BAR; PG8_WAIT_L(0); PG8_MMA(0, 1, At, B1); PG8_BAR;
            PG8_LDA(At, 1, 1); PG8_STAGE(PG8_SA(1, 0), a3, voffA);
            PG8_BAR; PG8_WAIT_L(0); PG8_MMA(1, 0, At, B0); PG8_BAR; PG8_SCHED;
            PG8_STAGE(PG8_SB(1, 1), b3 + hstepB, voffB);
            PG8_WAIT_V(6); PG8_BAR; PG8_MMA(1, 1, At, B1); PG8_BAR;
            }
        }
        if constexpr (ALIGN) { if (wr == 0) PG8_BAR; }
        const bool consumed = E(acc, cur, wr, wc, fr, fq);
        if (!has_next) break;
        if (consumed)
#pragma unroll
        for (int a = 0; a < 2; ++a)
#pragma unroll
            for (int b = 0; b < 2; ++b)
#pragma unroll
                for (int m = 0; m < 4; ++m)
#pragma unroll
                    for (int n = 0; n < 2; ++n) acc[a][b][m][n] = (f32x4){0.f, 0.f, 0.f, 0.f};
        cur = nxt; cA = nA; cB = nB; nt = cur.nt; ++ui;
        if constexpr (ALIGN) { if (wr == 1) PG8_BAR; }
    }
    PG8_WAIT_V(0);
    if constexpr (!ALIGN) { if (wr == 0) PG8_BAR; }
    PG8_BAR;
#undef PG8_SA
#undef PG8_SB
#undef PG8_STAGE
#undef PG8_LDA
#undef PG8_LDB
#undef PG8_MMA
#undef PG8_WAIT_V
#undef PG8_WAIT_L
#undef PG8_BAR
#undef PG8_SCHED
}
}

constexpr int branch_list(int mask) { int r = 0, n = 0; for (int b = 0; b < 4; ++b) if ((mask >> b) & 1) { r |= b << (4 * n); ++n; } return r; }
struct Args {
    const float* x; const float* ffn1_norm; const float* ffn1_w13; const float* ffn1_w2; const float* mix_norm; const float* w_in; const float* lb_logits; const float* hgrn_norm;
    const float* sinks; const float* w_branch; const float* w_out; const float* ffn2_norm; const float* ffn2_w13; const float* ffn2_w2; const float* rel_bias;
    float* out; unsigned char* ws;
    int l_lo, l_hi, ph_lo, ph_hi;
};

struct ConvDesc { const float* W; const float* gk; bf16_t* WT; unsigned char* W8; int K, N, k0, n0, drow0; float wscale; };
__device__ __forceinline__ ConvDesc conv_desc(const Args& a, int l, int it) {
    unsigned char* ws = a.ws;
    constexpr int I13 = (DM / 128) * (2 * DFF / 64), I2 = (DFF / 128) * (DM / 64), IIN = (DM / 128) * (NIN / 64), IBR = (BRT / 128) * (DM / 64);
    ConvDesc d; d.gk = nullptr; d.W8 = nullptr; d.WT = nullptr; d.wscale = 1.0f;
    int r = it;
    if (r < 2 * I13) {
        const bool second = r >= I13; if (second) r -= I13;
        d.W = (second ? a.ffn2_w13 : a.ffn1_w13) + (size_t)l * DM * 2 * DFF; d.WT = (bf16_t*)(ws + (second ? WS_W13B : WS_W13A));
        const int nblk = 2 * DFF / 64, kb = r / nblk, nb = r % nblk, n0 = 64 * nb;
        const int isup = n0 >= DFF; const int j = isup ? n0 - DFF : n0;
        d.K = DM; d.N = 2 * DFF; d.k0 = 128 * kb; d.n0 = n0; d.drow0 = 256 * (j / 128) + (isup ? 128 : 0) + (j % 128);
        d.gk = (second ? a.ffn2_norm : a.ffn1_norm) + (size_t)(l * 2) * DM; d.wscale = __uint_as_float((unsigned)__builtin_amdgcn_readfirstlane((int)(isup ? 0xbf317218u : 0xbfb8aa3bu))); return d; }
    r -= 2 * I13;
    if (r < 2 * I2) {
        const bool second = r >= I2; if (second) r -= I2;
        d.W = (second ? a.ffn2_w2 : a.ffn1_w2) + (size_t)l * DFF * DM; d.WT = (bf16_t*)(ws + (second ? WS_W2B : WS_W2A));
        const int nblk = DM / 64, kb = r / nblk, nb = r % nblk;
        d.K = DFF; d.N = DM; d.k0 = 128 * kb; d.n0 = 64 * nb; d.drow0 = 64 * nb; return d; }
    r -= 2 * I2;
    if (r < IIN) { const int nblk = NIN / 64, kb = r / nblk, nb = r % nblk;
        d.W = a.w_in + (size_t)l * DM * NIN; d.K = DM; d.N = NIN; d.k0 = 128 * kb; d.n0 = 64 * nb; d.gk = a.mix_norm + (size_t)(l * 2) * DM;
        if (64 * nb >= MIXIN && ((F8MASK >> ((64 * nb - MIXIN) / DM)) & 1)) { d.W8 = ws + WS_WG8; d.drow0 = 64 * nb - MIXIN; d.wscale = GATE_WSCALE; }
        else { d.WT = (bf16_t*)(ws + WS_WIN); d.drow0 = 64 * nb; }
        return d; }
    r -= IIN;
    if (r < IBR) { const int nblk = DM / 64, kb = r / nblk, nb = r % nblk;
        d.W = a.w_branch + (size_t)l * BRT * DM; d.WT = (bf16_t*)(ws + WS_WBR); d.K = BRT; d.N = DM; d.k0 = 128 * kb; d.n0 = 64 * nb; d.drow0 = 64 * nb; return d; }
    r -= IBR;
    { const int nblk = DM / 64, kb = r / nblk, nb = r % nblk;
        d.W = a.w_out + (size_t)l * DM * DM; d.WT = (bf16_t*)(ws + WS_WOUT); d.K = DM; d.N = DM; d.k0 = 128 * kb; d.n0 = 64 * nb; d.drow0 = 64 * nb; return d; }
}
__device__ __forceinline__ void conv_load(const ConvDesc& d, float (&v)[16], int wave, int lane) {
#pragma unroll
    for (int i = 0; i < 16; ++i) { const int k = d.k0 + wave * 16 + i; v[i] = d.W[(size_t)k * d.N + d.n0 + lane] * ((d.gk ? d.gk[k] : 1.0f) * d.wscale); }
}
__device__ __forceinline__ void convert_weights(const Args& a, int l, LAS unsigned char* lds, int bid, int G, int lane, int wave) {
    LAS float* tile = (LAS float*)lds;
    constexpr int I13 = (DM / 128) * (2 * DFF / 64), I2 = (DFF / 128) * (DM / 64), IIN = (DM / 128) * (NIN / 64), IBR = (BRT / 128) * (DM / 64), IOUT = (DM / 128) * (DM / 64);
    constexpr int NITEMS = 2 * I13 + 2 * I2 + IIN + IBR + IOUT;
    asm volatile("" : "+s"(bid));
    if (bid >= NITEMS) return;
    float v[16];
    { const ConvDesc d0 = conv_desc(a, l, bid); conv_load(d0, v, wave, lane); }
    for (int it = bid; it < NITEMS; it += G) {
        __syncthreads();
#pragma unroll
        for (int i = 0; i < 16; ++i) tile[(wave * 16 + i) * 65 + lane] = v[i];
        __syncthreads();
        if (it + G < NITEMS) { const ConvDesc dn = conv_desc(a, l, it + G); conv_load(dn, v, wave, lane); }
        const ConvDesc c = conv_desc(a, l, it);
#pragma unroll
        for (int j = 0; j < 8; ++j) { const int n = wave * 8 + j; const float lo = tile[(2 * lane) * 65 + n], hi = tile[(2 * lane + 1) * 65 + n];
            if (c.W8) *(unsigned short*)(c.W8 + (size_t)(c.drow0 + n) * c.K + c.k0 + 2 * lane) = (unsigned short)(__builtin_amdgcn_cvt_pk_fp8_f32(lo, hi, 0, false) & 0xffff);
            else *(unsigned*)(c.WT + (size_t)(c.drow0 + n) * c.K + c.k0 + 2 * lane) = cvt_pk_b16(lo, hi); }
    }
}

__device__ __forceinline__ void prenorm_rows(const float* x, bf16_t* xn, float* rstd_out, int gw, int NGW, int lane) {
    for (int m = gw; m < M; m += NGW) {
        const float* xr = x + (size_t)m * DM; float v[32]; float ss = 0.f;
#pragma unroll
        for (int j = 0; j < 4; ++j) { const f32x4 a0 = *(const f32x4*)(xr + 512 * j + 8 * lane), a1 = *(const f32x4*)(xr + 512 * j + 8 * lane + 4);
#pragma unroll
            for (int e = 0; e < 4; ++e) { v[8 * j + e] = a0[e]; v[8 * j + 4 + e] = a1[e]; ss += a0[e] * a0[e] + a1[e] * a1[e]; } }
        const float rstd = rsqrtf(wave_sum(ss) * (1.0f / DM) + EPS);
#pragma unroll
        for (int j = 0; j < 4; ++j) {
            u32x4 w; w.x = cvt_pk_b16(v[8 * j + 0] * rstd, v[8 * j + 1] * rstd); w.y = cvt_pk_b16(v[8 * j + 2] * rstd, v[8 * j + 3] * rstd);
            w.z = cvt_pk_b16(v[8 * j + 4] * rstd, v[8 * j + 5] * rstd); w.w = cvt_pk_b16(v[8 * j + 6] * rstd, v[8 * j + 7] * rstd);
            *(u32x4*)(xn + (size_t)m * DM + 512 * j + 8 * lane) = w; }
        if (lane == 0) rstd_out[m] = rstd;
    }
}
__device__ __forceinline__ void resnorm_rows(const bf16_t* f, bf16_t* xn, float* rstd, float* hout32, float coef, const float* g_post, int gw, int NGW, int lane, unsigned char* xn8 = nullptr) {
    float gp[32];
#pragma unroll
    for (int j = 0; j < 4; ++j) { const f32x4 a0 = *(const f32x4*)(g_post + 512 * j + 8 * lane), a1 = *(const f32x4*)(g_post + 512 * j + 8 * lane + 4);
#pragma unroll
        for (int e = 0; e < 4; ++e) { gp[8 * j + e] = a0[e] * coef; gp[8 * j + 4 + e] = a1[e] * coef; } }
    u32x4 fw[4], hw[4]; float rprev = 1.0f;
#pragma unroll
    for (int j = 0; j < 4; ++j) { fw[j] = (u32x4){0u, 0u, 0u, 0u}; hw[j] = (u32x4){0u, 0u, 0u, 0u}; }
    auto issue = [&](int m) {
#pragma unroll
        for (int j = 0; j < 4; ++j) { const size_t off = (size_t)m * DM + 512 * j + 8 * lane; fw[j] = *(const u32x4*)(f + off); hw[j] = *(const u32x4*)(xn + off); }
        rprev = rstd[m]; };
    if (gw < M) issue(gw);
    for (int m = gw; m < M; m += NGW) {
        float fv[32], hv[32]; float ss = 0.f; const float hs = 1.0f / rprev;
#pragma unroll
        for (int j = 0; j < 4; ++j) { const u32x4 w = fw[j];
            fv[8 * j + 0] = bflo(w.x); fv[8 * j + 1] = bfhi(w.x); fv[8 * j + 2] = bflo(w.y); fv[8 * j + 3] = bfhi(w.y); fv[8 * j + 4] = bflo(w.z); fv[8 * j + 5] = bfhi(w.z); fv[8 * j + 6] = bflo(w.w); fv[8 * j + 7] = bfhi(w.w);
            const u32x4 h4 = hw[j];
            hv[8 * j + 0] = b16lo(h4.x) * hs; hv[8 * j + 1] = b16hi(h4.x) * hs; hv[8 * j + 2] = b16lo(h4.y) * hs; hv[8 * j + 3] = b16hi(h4.y) * hs; hv[8 * j + 4] = b16lo(h4.z) * hs; hv[8 * j + 5] = b16hi(h4.z) * hs; hv[8 * j + 6] = b16lo(h4.w) * hs; hv[8 * j + 7] = b16hi(h4.w) * hs;
#pragma unroll
            for (int e = 0; e < 8; ++e) ss += fv[8 * j + e] * fv[8 * j + e]; }
        if (m + NGW < M) issue(m + NGW);
        const float rs = rsqrtf(wave_sum(ss) * (1.0f / DM) + EPS);
        float ss2 = 0.f;
#pragma unroll
        for (int j = 0; j < 4; ++j) {
#pragma unroll
            for (int e = 0; e < 8; ++e) { const float o = hv[8 * j + e] + fv[8 * j + e] * rs * gp[8 * j + e]; ss2 += o * o; fv[8 * j + e] = o; }
            if (hout32) { const size_t off = (size_t)m * DM + 512 * j + 8 * lane;
                *(f32x4*)(hout32 + off) = (f32x4){fv[8 * j + 0], fv[8 * j + 1], fv[8 * j + 2], fv[8 * j + 3]}; *(f32x4*)(hout32 + off + 4) = (f32x4){fv[8 * j + 4], fv[8 * j + 5], fv[8 * j + 6], fv[8 * j + 7]}; } }
        if (!hout32) {
            const float rn = rsqrtf(wave_sum(ss2) * (1.0f / DM) + EPS);
#pragma unroll
            for (int j = 0; j < 4; ++j) {
                u32x4 w; w.x = cvt_pk_b16(fv[8 * j + 0] * rn, fv[8 * j + 1] * rn); w.y = cvt_pk_b16(fv[8 * j + 2] * rn, fv[8 * j + 3] * rn);
                w.z = cvt_pk_b16(fv[8 * j + 4] * rn, fv[8 * j + 5] * rn); w.w = cvt_pk_b16(fv[8 * j + 6] * rn, fv[8 * j + 7] * rn);
                *(u32x4*)(xn + (size_t)m * DM + 512 * j + 8 * lane) = w;
                if (xn8) { u32x2 b; b.x = pk_fp8x4(fv[8 * j + 0] * rn, fv[8 * j + 1] * rn, fv[8 * j + 2] * rn, fv[8 * j + 3] * rn); b.y = pk_fp8x4(fv[8 * j + 4] * rn, fv[8 * j + 5] * rn, fv[8 * j + 6] * rn, fv[8 * j + 7] * rn);
                    *(u32x2*)(xn8 + (size_t)m * DM + 512 * j + 8 * lane) = b; } }
            if (lane == 0) rstd[m] = rn;
        }
    }
}

__device__ __forceinline__ int rel_bucket(int dist) {
    if (dist < 16) return dist;
    const float d = (float)dist;
    int large = 16 + (int)(logf(d / 16.0f) / 4.852030263919617f * 16.0f);
    return large < 31 ? large : 31;
}

struct WinArgs {
    const bf16_t* q; const bf16_t* k; const bf16_t* v;
    long rstride;
    int first;
    int maxdist;
    const float* biascol; int dil;
    float sink; int has_sink;
    bf16_t* out; long ostride;
    float* lse; long lstride;
};
constexpr int AW_KS = 0, AW_VT = 36864, AW_PS = 36864 + 36864, AW_BT = AW_PS + 8 * 5376;
struct WinRegs { u32x4 k[4], v[4]; bf16x8 q0, q1; float bias; };
__device__ __forceinline__ void win_fetch(const WinArgs& A, int tid, int wave, int lane, WinRegs& R) {
#pragma unroll
    for (int i = 0; i < 4; ++i) {
        const int cidx = tid + 512 * i, j = cidx >> 3, part = cidx & 7;
        R.k[i] = (u32x4){0u, 0u, 0u, 0u}; R.v[i] = (u32x4){0u, 0u, 0u, 0u};
        if (!(A.first && j < 128)) { R.k[i] = *(const u32x4*)(A.k + (long)j * A.rstride + part * 8); R.v[i] = *(const u32x4*)(A.v + (long)j * A.rstride + part * 8); }
    }
    const bf16_t* qrow = A.q + (long)(16 * wave + (lane & 15)) * A.rstride;
    R.q0 = *(const bf16x8*)(qrow + 8 * (lane >> 4)); R.q1 = *(const bf16x8*)(qrow + 32 + 8 * (lane >> 4));
    R.bias = -3.0e38f;
    if (tid < 384) { const int dd = tid - 128; if (dd >= 0 && dd <= A.maxdist) R.bias = A.biascol[rel_bucket(dd * A.dil) * 20]; }
}
__device__ __forceinline__ void attn_win_item(LAS unsigned char* lds, const WinArgs& A, WinRegs& R, bool hasnext, const WinArgs& An, int tid, int wave, int lane) {
    LAS bf16_t* KS = (LAS bf16_t*)(lds + AW_KS);
    LAS bf16_t* VT = (LAS bf16_t*)(lds + AW_VT);
    LAS bf16_t* PS = (LAS bf16_t*)(lds + AW_PS) + wave * (16 * 168);
    LAS float* BT = (LAS float*)(lds + AW_BT);
    __syncthreads();
#pragma unroll
    for (int i = 0; i < 4; ++i) {
        const int cidx = tid + 512 * i, j = cidx >> 3, part = cidx & 7;
        *(LAS u32x4*)(KS + j * 72 + part * 8) = R.k[i];
        *(LAS u32x4*)(VT + j * 72 + part * 8) = R.v[i];
    }
    if (tid < 384) BT[tid] = R.bias;
    const bf16x8 qa0 = R.q0, qa1 = R.q1;
    __syncthreads();
    if (hasnext) win_fetch(An, tid, wave, lane, R);
    const int c = lane & 15, g = lane >> 4, st = wave < 6 ? wave : 6;
    f32x4 s[10];
#pragma unroll
    for (int jt = 0; jt < 10; ++jt) {
        const LAS bf16_t* kr = KS + (16 * (st + jt) + c) * 72 + 8 * g;
        const bf16x8 kb0 = *(const LAS bf16x8*)kr, kb1 = *(const LAS bf16x8*)(kr + 32);
        f32x4 z = (f32x4){0.f, 0.f, 0.f, 0.f};
        z = MFMA16(qa0, kb0, z);
        z = MFMA16(qa1, kb1, z);
        s[jt] = z;
    }
    float mx[4] = {-3.0e38f, -3.0e38f, -3.0e38f, -3.0e38f};
    { const LAS float* bp = BT + (16 * wave + 4 * g - 16 * st - c + 256 - 144);
#pragma unroll
      for (int jt = 0; jt < 10; ++jt) {
#pragma unroll
          for (int i = 0; i < 4; ++i) { const float lg = s[jt][i] * 0.125f + bp[144 + i - 16 * jt]; s[jt][i] = lg; mx[i] = fmaxf(mx[i], lg); } }
      if (A.first) {
#pragma unroll
          for (int jt = 0; jt < 10; ++jt) { if (16 * (st + jt) + c < 128) {
#pragma unroll
              for (int i = 0; i < 4; ++i) s[jt][i] = -3.0e38f; } }
#pragma unroll
          for (int i = 0; i < 4; ++i) { mx[i] = -3.0e38f;
#pragma unroll
              for (int jt = 0; jt < 10; ++jt) mx[i] = fmaxf(mx[i], s[jt][i]); } } }
#pragma unroll
    for (int i = 0; i < 4; ++i) {
        mx[i] = row16_max(mx[i]);
        if (A.has_sink) mx[i] = fmaxf(mx[i], A.sink);
    }
    float sm[4] = {0.f, 0.f, 0.f, 0.f};
#pragma unroll
    for (int jt = 0; jt < 10; ++jt) {
#pragma unroll
        for (int i = 0; i < 4; ++i) {
            const float p = __expf(s[jt][i] - mx[i]);
            sm[i] += p;
            PS[(4 * g + i) * 168 + 16 * jt + c] = f2bf(p);
        }
    }
#pragma unroll
    for (int i = 0; i < 4; ++i) {
        sm[i] = row16_sum(sm[i]);
        if (A.has_sink) sm[i] += __expf(A.sink - mx[i]);
    }
    LDS_WAIT();
    f32x4 o[4];
#pragma unroll
    for (int dt = 0; dt < 4; ++dt) o[dt] = (f32x4){0.f, 0.f, 0.f, 0.f};
    const unsigned vaddr = lds_addr(VT + (16 * st + 8 * g + (c >> 2)) * 72 + 4 * (c & 3));
#pragma unroll
    for (int ks = 0; ks < 5; ++ks) {
        const bf16x8 pa = *(const LAS bf16x8*)(PS + c * 168 + 32 * ks + 8 * g);
        bf16x8 vb[4]; tr_frag4<576>(vaddr + ks * (32 * 144), vb);
#pragma unroll
        for (int dt = 0; dt < 4; ++dt) o[dt] = MFMA16(pa, vb[dt], o[dt]);
    }
#pragma unroll
    for (int i = 0; i < 4; ++i) {
        const float inv = 1.0f / sm[i];
        bf16_t* orow = A.out + (long)(16 * wave + 4 * g + i) * A.ostride;
#pragma unroll
        for (int dt = 0; dt < 4; ++dt) orow[16 * dt + c] = A.has_sink ? f2b16(o[dt][i] * inv) : f2bf(o[dt][i] * inv);
        if (A.lse && c == 0) A.lse[(long)(16 * wave + 4 * g + i) * A.lstride] = mx[i] + __logf(sm[i]);
    }
}

constexpr float SB_THR = -30.0f;
constexpr int SB_KS = 0, SB_VT = 18432, SB_PS = 18432 + 18432;
__device__ __forceinline__ void stickbreak_item(LAS unsigned char* lds, volatile LAS unsigned* flag, const bf16_t* proj, bf16_t* yall, int b, int h, int nb, int tid, int wave, int lane) {
    LAS bf16_t* KS = (LAS bf16_t*)(lds + SB_KS);
    LAS bf16_t* VT = (LAS bf16_t*)(lds + SB_VT);
    LAS bf16_t* PS = (LAS bf16_t*)(lds + SB_PS) + wave * (16 * 136);
    const int c = lane & 15, g = lane >> 4;
    const long tok0 = (long)b * SEQ + 128 * nb;
    const bf16_t* qrow = proj + (tok0 + 16 * wave + c) * MIXIN + BQ + h * 64;
    const bf16x8 qa0 = *(const bf16x8*)(qrow + 8 * g), qa1 = *(const bf16x8*)(qrow + 32 + 8 * g);
    float R[4] = {0.f, 0.f, 0.f, 0.f};
    f32x4 o[4];
#pragma unroll
    for (int dt = 0; dt < 4; ++dt) o[dt] = (f32x4){0.f, 0.f, 0.f, 0.f};
    bool wdone = false;
    if (tid == 0) flag[0] = 0u;
    for (int kb = nb; kb >= 0; --kb) {
        __syncthreads();
        const bf16_t* kbase = proj + ((long)b * SEQ + 128 * kb) * MIXIN + h * 64;
#pragma unroll
        for (int i = 0; i < 2; ++i) {
            const int cidx = tid + 512 * i, j = cidx >> 3, part = cidx & 7;
            const u32x4 kw = *(const u32x4*)(kbase + (long)j * MIXIN + BKo + part * 8), vw = *(const u32x4*)(kbase + (long)j * MIXIN + BVo + part * 8);
            *(LAS u32x4*)(KS + j * 72 + part * 8) = kw;
            *(LAS u32x4*)(VT + j * 72 + part * 8) = vw;
        }
        __syncthreads();
        if (!wdone) {
            const bool diag = (kb == nb);
            const int jt_hi = diag ? wave : 7;
            if (diag) { for (int jt = wave + 1; jt < 8; ++jt) {
#pragma unroll
                    for (int i = 0; i < 4; ++i) PS[(4 * g + i) * 136 + 16 * jt + c] = 0; } }
            for (int jt = jt_hi; jt >= 0; --jt) {
                const LAS bf16_t* kr = KS + (16 * jt + c) * 72 + 8 * g;
                const bf16x8 kb0 = *(const LAS bf16x8*)kr, kb1 = *(const LAS bf16x8*)(kr + 32);
                f32x4 z = (f32x4){0.f, 0.f, 0.f, 0.f};
                z = MFMA16(qa0, kb0, z);
                z = MFMA16(qa1, kb1, z);
#pragma unroll
                for (int i = 0; i < 4; ++i) {
                    const float zz = z[i] * 0.125f;
                    const bool past = !diag || jt < wave || c < 4 * g + i;
                    const float sp = fmaxf(zz, 0.f) + __logf(1.0f + __expf(-fabsf(zz)));
                    const float lk = past ? -sp : 0.f;
                    float inc = lk;
                    inc += dpp_f<0x101>(inc); inc += dpp_f<0x102>(inc); inc += dpp_f<0x104>(inc); inc += dpp_f<0x108>(inc);
                    const float between = R[i] + inc - lk;
                    const float a = past ? __expf(zz - sp + between) : 0.f;
                    R[i] += __shfl(inc, 0, 16);
                    PS[(4 * g + i) * 136 + 16 * jt + c] = f2bf(a);
                }
                if (jt > 0 && __all(fmaxf(fmaxf(R[0], R[1]), fmaxf(R[2], R[3])) < SB_THR)) {
                    for (int j2 = jt - 1; j2 >= 0; --j2) {
#pragma unroll
                        for (int i = 0; i < 4; ++i) PS[(4 * g + i) * 136 + 16 * j2 + c] = 0; }
                    break; }
            }
            LDS_WAIT();
#pragma unroll
            for (int ks = 0; ks < 4; ++ks) {
                const bf16x8 pa = *(const LAS bf16x8*)(PS + c * 136 + 32 * ks + 8 * g);
                bf16x8 vb[4]; tr_frag4<576>(lds_addr(VT + (8 * g + (c >> 2)) * 72 + 4 * (c & 3)) + ks * (32 * 144), vb);
#pragma unroll
                for (int dt = 0; dt < 4; ++dt) o[dt] = MFMA16(pa, vb[dt], o[dt]);
            }
            const float rmax = fmaxf(fmaxf(R[0], R[1]), fmaxf(R[2], R[3]));
            wdone = __all(rmax < SB_THR);
        }
        if (!wdone && lane == 0) flag[0] = (unsigned)(kb + 1);
        __syncthreads();
        if (flag[0] != (unsigned)(kb + 1)) break;
    }
#pragma unroll
    for (int i = 0; i < 4; ++i) {
        bf16_t* orow = yall + (tok0 + 16 * wave + 4 * g + i) * BRT + 512 + h * 64;
#pragma unroll
        for (int dt = 0; dt < 4; ++dt) orow[16 * dt + c] = f2b16(o[dt][i]);
    }
}

constexpr int H1_GT = 0, H1_BR = 2048, H1_BL = 2560, H1_QS = 3072, H1_KS = H1_QS + 33792, H1_KDT = H1_KS + 33792, H1_VT = H1_KDT + 18432, H1_PS = H1_VT + 18432;
__device__ __forceinline__ void hgrn_a1_load(const Args& a, int item, int tid, unsigned (&fq)[16], unsigned (&vp)[8]) {
    const bf16_t* proj = (const bf16_t*)(a.ws + WS_PROJ);
    const int cch = item & 63, h = (item >> 6) & 3, b = item >> 8, k = tid & 127, rg = tid >> 7;
    const bf16_t* p = proj + ((long)b * SEQ + 64 * cch + 16 * rg) * MIXIN + h * 128 + k;
#pragma unroll
    for (int r = 0; r < 16; ++r) { const unsigned f = p[(long)r * MIXIN + AF], q = p[(long)r * MIXIN + AQ], v = p[(long)r * MIXIN + AI]; fq[r] = f | (q << 16); if (r & 1) vp[r >> 1] |= v << 16; else vp[r >> 1] = v; }
}
__device__ __forceinline__ void hgrn_a1_item(LAS unsigned char* lds, const Args& a, int l, int item, int next_item, unsigned (&fq)[16], unsigned (&vp)[8], int tid, int wave, int lane) {
    const int cch = item & 63, h = (item >> 6) & 3, b = item >> 8;
    const long tok0 = (long)b * SEQ + 64 * cch;
    LAS float* GT = (LAS float*)(lds + H1_GT);
    LAS float* BR = (LAS float*)(lds + H1_BR);
    LAS float* BL = (LAS float*)(lds + H1_BL);
    LAS float* QS = (LAS float*)(lds + H1_QS);
    LAS float* KS = (LAS float*)(lds + H1_KS);
    LAS bf16_t* KDT = (LAS bf16_t*)(lds + H1_KDT);
    LAS bf16_t* VT = (LAS bf16_t*)(lds + H1_VT);
    LAS bf16_t* PS = (LAS bf16_t*)(lds + H1_PS);
    const int k = tid & 127, rg = tid >> 7;
    float lb;
    { const float* lg = a.lb_logits + h * 128 + k; const float l0 = lg[0], l1 = lg[512], l2 = lg[1024], l3 = lg[1536];
      const float mxl = fmaxf(fmaxf(l0, l1), fmaxf(l2, l3)); const float e0 = __expf(l0 - mxl), e1 = __expf(l1 - mxl), e2 = __expf(l2 - mxl), e3 = __expf(l3 - mxl);
      const float inv = 1.0f / (e0 + e1 + e2 + e3);
      lb = (l >= 1 ? e1 : 0.f) + (l >= 2 ? e2 : 0.f) + (l >= 3 ? e3 : 0.f); lb *= inv; }
    __syncthreads();
    float kk[16], bb[16];
    { float run = 0.f;
#pragma unroll
      for (int r = 0; r < 16; ++r) { const float fl = bf2f((bf16_t)(fq[r] & 0xffffu));
          const float f = lb + (1.0f - lb) * fast_sigmoid(fl); kk[r] = 1.0f - f; run += __logf(f); bb[r] = run; }
      GT[rg * 128 + k] = run; }
    __syncthreads();
    { float pre = 0.f;
#pragma unroll
      for (int r2 = 0; r2 < 3; ++r2) pre += (r2 < rg) ? GT[r2 * 128 + k] : 0.f;
#pragma unroll
      for (int r = 0; r < 16; ++r) bb[r] += pre;
      if (rg == 1) BR[k] = bb[15];
      if (rg == 3) BL[k] = bb[15]; }
    __syncthreads();
    { const float bref = BR[k], blast = BL[k];
      bf16_t* qi_out = (bf16_t*)(a.ws + WS_QI) + ((size_t)item * 64 + 16 * rg) * 128 + k;
      unsigned kd[8];
#pragma unroll
      for (int r = 0; r < 16; ++r) {
          const float q = bf2f((bf16_t)(fq[r] >> 16));
          const float qs = q * __expf(bb[r] - bref), ks = kk[r] * __expf(bref - bb[r]), kdv = kk[r] * __expf(blast - bb[r]), qi = q * __expf(bb[r]);
          QS[(16 * rg + r) * 132 + k] = qs; KS[(16 * rg + r) * 132 + k] = ks;
          qi_out[(size_t)r * 128] = f2bf(qi);
          const unsigned kdb = f2bf(kdv);
          if (r & 1) kd[r >> 1] |= kdb << 16; else kd[r >> 1] = kdb;
      }
      *(LAS u32x4*)(KDT + k * 72 + 16 * rg) = (u32x4){kd[0], kd[1], kd[2], kd[3]}; *(LAS u32x4*)(KDT + k * 72 + 16 * rg + 8) = (u32x4){kd[4], kd[5], kd[6], kd[7]};
      *(LAS u32x4*)(VT + k * 72 + 16 * rg) = (u32x4){vp[0], vp[1], vp[2], vp[3]}; *(LAS u32x4*)(VT + k * 72 + 16 * rg + 8) = (u32x4){vp[4], vp[5], vp[6], vp[7]};
      if (rg == 3) ((float*)(a.ws + WS_DC))[(size_t)item * 128 + k] = __expf(blast); }
    if (next_item >= 0) hgrn_a1_load(a, next_item, tid, fq, vp);
    __syncthreads();
    const int c = lane & 15, g = lane >> 4;
    { const int mt = wave >> 1;
#pragma unroll
      for (int e = 0; e < 2; ++e) { const int nt = 2 * (wave & 1) + e;
          f32x4 z = (f32x4){0.f, 0.f, 0.f, 0.f};
          if (nt <= mt) {
#pragma unroll
              for (int Mi = 0; Mi < 8; ++Mi) { const f32x4 a4 = *(const LAS f32x4*)(QS + (16 * mt + c) * 132 + 16 * Mi + 4 * g), b4 = *(const LAS f32x4*)(KS + (16 * nt + c) * 132 + 16 * Mi + 4 * g);
#pragma unroll
                  for (int j = 0; j < 4; ++j) z = __builtin_amdgcn_mfma_f32_16x16x4f32(a4[j], b4[j], z, 0, 0, 0); } }
#pragma unroll
          for (int i = 0; i < 4; ++i) { const int t = 16 * mt + 4 * g + i, s = 16 * nt + c; PS[t * 72 + s] = (s <= t) ? f2bf(z[i]) : (bf16_t)0; } } }
    __syncthreads();
    { const int mt = wave >> 1;
      bf16_t* oi = (bf16_t*)(a.ws + WS_OINTRA) + (size_t)item * 64 * 128;
      bf16x8 pa[2];
#pragma unroll
      for (int ks = 0; ks < 2; ++ks) pa[ks] = *(const LAS bf16x8*)(PS + (16 * mt + c) * 72 + 32 * ks + 8 * g);
#pragma unroll
      for (int e = 0; e < 4; ++e) { const int vt = 4 * (wave & 1) + e; f32x4 z = (f32x4){0.f, 0.f, 0.f, 0.f};
#pragma unroll
          for (int ks = 0; ks < 2; ++ks) { const bf16x8 vb = *(const LAS bf16x8*)(VT + (16 * vt + c) * 72 + 32 * ks + 8 * g); z = MFMA16(vb, pa[ks], z); }
          u32x2 w; w.x = cvt_pk_bf16(z[0], z[1]); w.y = cvt_pk_bf16(z[2], z[3]); *(u32x2*)(oi + (size_t)(16 * mt + c) * 128 + 16 * vt + 4 * g) = w; }
      bf16_t* U = (bf16_t*)(a.ws + WS_U) + (size_t)item * 128 * 128;
      bf16x8 ka[2];
#pragma unroll
      for (int ks = 0; ks < 2; ++ks) ka[ks] = *(const LAS bf16x8*)(KDT + (16 * wave + c) * 72 + 32 * ks + 8 * g);
#pragma unroll
      for (int vt = 0; vt < 8; ++vt) { f32x4 z = (f32x4){0.f, 0.f, 0.f, 0.f};
#pragma unroll
          for (int ks = 0; ks < 2; ++ks) { const bf16x8 vb = *(const LAS bf16x8*)(VT + (16 * vt + c) * 72 + 32 * ks + 8 * g); z = MFMA16(vb, ka[ks], z); }
          u32x2 w; w.x = cvt_pk_bf16(z[0], z[1]); w.y = cvt_pk_bf16(z[2], z[3]); *(u32x2*)(U + (size_t)(16 * wave + c) * 128 + 16 * vt + 4 * g) = w; } }
}
__device__ __forceinline__ void hgrn_a2(const Args& a, int gtid, int gthreads) {
    const bf16_t* U = (const bf16_t*)(a.ws + WS_U); const float* DC = (const float*)(a.ws + WS_DC); bf16_t* SP = (bf16_t*)(a.ws + WS_SPREV);
    for (int e = gtid; e < 32 * 128 * 32; e += gthreads) {
        const int v4 = e & 31, k = (e >> 5) & 127, bh = e >> 12;
        f32x4 S = (f32x4){0.f, 0.f, 0.f, 0.f};
        u32x2 ub[8]; float db[8];
#pragma unroll
        for (int j = 0; j < 8; ++j) { const size_t it = (size_t)bh * 64 + j; ub[j] = *(const u32x2*)(U + (it * 128 + k) * 128 + 4 * v4); db[j] = DC[it * 128 + k]; }
        for (int c0 = 0; c0 < 64; c0 += 8) {
#pragma unroll
            for (int j = 0; j < 8; ++j) {
                const size_t it = (size_t)bh * 64 + c0 + j;
                const u32x2 uw = ub[j]; const float d = db[j];
                if (c0 + 8 < 64) { const size_t itn = it + 8; ub[j] = *(const u32x2*)(U + (itn * 128 + k) * 128 + 4 * v4); db[j] = DC[itn * 128 + k]; }
                const f32x4 u = (f32x4){bflo(uw.x), bfhi(uw.x), bflo(uw.y), bfhi(uw.y)};
                u32x2 w; w.x = cvt_pk_bf16(S[0], S[1]); w.y = cvt_pk_bf16(S[2], S[3]);
                *(u32x2*)(SP + (it * 128 + k) * 128 + 4 * v4) = w;
                S = S * d + u;
            }
        }
    }
}
constexpr int H3_ST = 0, H3_SS = 36864;
__device__ __forceinline__ void hgrn_a3_item(LAS unsigned char* lds, const Args& a, int l, int item, int tid, int wave, int lane) {
    const bf16_t* proj = (const bf16_t*)(a.ws + WS_PROJ); bf16_t* yall = (bf16_t*)(a.ws + WS_YALL);
    const int cch = item & 63, h = (item >> 6) & 3, b = item >> 8;
    const long tok0 = (long)b * SEQ + 64 * cch;
    LAS bf16_t* ST = (LAS bf16_t*)(lds + H3_ST); LAS float* SS = (LAS float*)(lds + H3_SS);
    const bf16_t* SP = (const bf16_t*)(a.ws + WS_SPREV) + (size_t)item * 128 * 128;
    __syncthreads();
#pragma unroll
    for (int i = 0; i < 4; ++i) { const int cidx = tid + 512 * i, kr = cidx >> 4, part = cidx & 15;
        const u32x4 w = *(const u32x4*)(SP + (size_t)kr * 128 + 8 * part);
        *(LAS u32x4*)(ST + kr * 144 + 8 * part) = w; }
    __syncthreads();
    const int c = lane & 15, g = lane >> 4, mt = wave >> 1;
    const bf16_t* qi = (const bf16_t*)(a.ws + WS_QI) + ((size_t)item * 64 + 16 * mt + c) * 128;
    const bf16_t* oi = (const bf16_t*)(a.ws + WS_OINTRA) + (size_t)item * 64 * 128;
    bf16x8 qa[4];
#pragma unroll
    for (int ks = 0; ks < 4; ++ks) qa[ks] = *(const bf16x8*)(qi + 32 * ks + 8 * g);
    f32x4 o[4];
#pragma unroll
    for (int e = 0; e < 4; ++e) o[e] = (f32x4){0.f, 0.f, 0.f, 0.f};
    { const unsigned saddr = lds_addr(ST + (8 * g + (c >> 2)) * 144 + 64 * (wave & 1) + 4 * (c & 3));
#pragma unroll
      for (int ks = 0; ks < 4; ++ks) { bf16x8 sb[4]; tr_frag4<1152>(saddr + ks * (32 * 288), sb);
#pragma unroll
          for (int e = 0; e < 4; ++e) o[e] = MFMA16(sb[e], qa[ks], o[e]); } }
    const int t = 16 * mt + c; float ss = 0.f;
#pragma unroll
    for (int e = 0; e < 4; ++e) { const int v0 = 16 * (4 * (wave & 1) + e) + 4 * g; const u32x2 w = *(const u32x2*)(oi + (size_t)t * 128 + v0);
        f32x4 z = o[e]; z[0] += bflo(w.x); z[1] += bfhi(w.x); z[2] += bflo(w.y); z[3] += bfhi(w.y);
        ss += (z[0] * z[0] + z[1] * z[1]) + (z[2] * z[2] + z[3] * z[3]); o[e] = z; }
    ss += __shfl_xor(ss, 16); ss += __shfl_xor(ss, 32);
    if (g == 0) SS[t * 2 + (wave & 1)] = ss;
    __syncthreads();
    { const float rstd = rsqrtf((SS[t * 2] + SS[t * 2 + 1]) * (1.0f / 128.0f) + EPS);
      const long tok = tok0 + t;
#pragma unroll
      for (int e = 0; e < 4; ++e) { const int v0 = 16 * (4 * (wave & 1) + e) + 4 * g;
          const u32x2 gw = *(const u32x2*)(proj + tok * MIXIN + AG + h * 128 + v0); const f32x4 ng = *(const f32x4*)(a.hgrn_norm + l * 128 + v0);
          const float gt[4] = {bflo(gw.x), bfhi(gw.x), bflo(gw.y), bfhi(gw.y)}; float y[4];
#pragma unroll
          for (int i = 0; i < 4; ++i) y[i] = o[e][i] * rstd * ng[i] * (gt[i] * fast_sigmoid(gt[i]));
          u32x2 w; w.x = cvt_pk_b16(y[0], y[1]); w.y = cvt_pk_b16(y[2], y[3]); *(u32x2*)(yall + tok * BRT + h * 128 + v0) = w; } }
}
__device__ __forceinline__ void c_combine(const Args& a, int gtid, int gthreads) {
    const bf16_t* CP = (const bf16_t*)(a.ws + WS_CPART); const float* LS = (const float*)(a.ws + WS_CLSE); bf16_t* yall = (bf16_t*)(a.ws + WS_YALL);
    for (int e = gtid; e < M * 32; e += gthreads) {
        const int part = e & 31, tok = e >> 5, h4 = part >> 3;
        const float l0 = LS[(size_t)tok * 4 + h4], l1 = LS[((size_t)M + tok) * 4 + h4], l2 = LS[((size_t)2 * M + tok) * 4 + h4];
        const float mx = fmaxf(l0, fmaxf(l1, l2)); float w0 = __expf(l0 - mx), w1 = __expf(l1 - mx), w2 = __expf(l2 - mx); const float inv = 1.0f / (w0 + w1 + w2); w0 *= inv; w1 *= inv; w2 *= inv;
        const u32x4 p0 = *(const u32x4*)(CP + (size_t)tok * 256 + 8 * part), p1 = *(const u32x4*)(CP + ((size_t)M + tok) * 256 + 8 * part), p2 = *(const u32x4*)(CP + ((size_t)2 * M + tok) * 256 + 8 * part);
        u32x4 o;
        o.x = cvt_pk_b16(w0 * bflo(p0.x) + w1 * bflo(p1.x) + w2 * bflo(p2.x), w0 * bfhi(p0.x) + w1 * bfhi(p1.x) + w2 * bfhi(p2.x));
        o.y = cvt_pk_b16(w0 * bflo(p0.y) + w1 * bflo(p1.y) + w2 * bflo(p2.y), w0 * bfhi(p0.y) + w1 * bfhi(p1.y) + w2 * bfhi(p2.y));
        o.z = cvt_pk_b16(w0 * bflo(p0.z) + w1 * bflo(p1.z) + w2 * bflo(p2.z), w0 * bfhi(p0.z) + w1 * bfhi(p1.z) + w2 * bfhi(p2.z));
        o.w = cvt_pk_b16(w0 * bflo(p0.w) + w1 * bflo(p1.w) + w2 * bflo(p2.w), w0 * bfhi(p0.w) + w1 * bfhi(p1.w) + w2 * bfhi(p2.w));
        *(u32x4*)(yall + (size_t)tok * BRT + 1024 + 8 * part) = o;
    }
}

__device__ __forceinline__ WinArgs win_args_c(const Args& a, const bf16_t* proj, int it) {
    const int sub = it & 31, h4 = (it >> 5) & 3, bg = it >> 7, g = bg % 3, b = bg / 3;
    const int r = g == 0 ? 1 : (g == 1 ? 4 : 16); const int nper = 32 / r, res = sub / nper, n = sub % nper;
    const long tq = (long)b * SEQ + (long)(128 * n) * r + res, tk = tq - (long)128 * r;
    WinArgs W; W.q = proj + tq * MIXIN + CQ + g * 256 + h4 * 64; W.k = proj + tk * MIXIN + CKo + g * 256 + h4 * 64; W.v = proj + tk * MIXIN + CVo + g * 256 + h4 * 64;
    W.rstride = (long)r * MIXIN; W.first = (n == 0); W.maxdist = 128; W.biascol = a.rel_bias + g * 4 + h4; W.dil = r; W.sink = 0.f; W.has_sink = 0;
    W.out = (bf16_t*)(a.ws + WS_CPART) + ((size_t)g * M + tq) * 256 + h4 * 64; W.ostride = (long)r * 256;
    W.lse = (float*)(a.ws + WS_CLSE) + ((size_t)g * M + tq) * 4 + h4; W.lstride = (long)r * 4;
    return W;
}
__device__ __forceinline__ WinArgs win_args_d(const Args& a, const bf16_t* proj, bf16_t* yall, int l, int it) {
    const int nb = it & 31, hq = (it >> 5) & 7, b = it >> 8, kvh = hq >> 2;
    const long tq = (long)b * SEQ + 128 * nb, tk = tq - 128;
    WinArgs W; W.q = proj + tq * MIXIN + DQo + hq * 64; W.k = proj + tk * MIXIN + DKo + kvh * 64; W.v = proj + tk * MIXIN + DVo + kvh * 64;
    W.rstride = MIXIN; W.first = (nb == 0); W.maxdist = 127; W.biascol = a.rel_bias + 12 + hq; W.dil = 1; W.sink = a.sinks[l * 8 + hq]; W.has_sink = 1;
    W.out = yall + tq * BRT + 1280 + hq * 64; W.ostride = BRT; W.lse = nullptr; W.lstride = 0;
    return W;
}

constexpr int LDS_BYTES = 147456;
constexpr int LDS_MISC = 131072;
constexpr int NPH = 14;

__global__ void __launch_bounds__(512, 2) fwd_kernel(Args a) {
    extern __shared__ __attribute__((aligned(16))) unsigned char lds_raw[];
    LAS unsigned char* lds = (LAS unsigned char*)lds_raw;
    const int G = gridDim.x, bid = blockIdx.x;
    const int NGW = G * 8, gthreads = G * 512;
#define LAUNDER() int tid_ = threadIdx.x; asm volatile("" : "+v"(tid_)); const int tid = tid_, lane = tid & 63, wave = __builtin_amdgcn_readfirstlane(tid >> 6), gw = bid * 8 + wave, gtid = bid * 512 + tid; (void)lane; (void)gw; (void)gtid
    unsigned char* ws = a.ws;
    volatile LAS unsigned* MISC = (volatile LAS unsigned*)(lds + LDS_MISC);
    if (threadIdx.x < 64) MISC[threadIdx.x] = 0u;
    __syncthreads();
#if MK_ONE_LAUNCH
    XcdBarrier bar = xcd_barrier_post((unsigned*)(ws + WS_CTL) + CW_BAR, MISC + 8);
#define GRID_BAR() xcd_barrier(bar)
#else
#define GRID_BAR() do { } while (0)
#endif
    bf16_t* XN = (bf16_t*)(ws + WS_H16);
    float* RSTD = (float*)(ws + WS_CTL + 512 * 1024);
    for (int l = a.l_lo; l < a.l_hi; ++l) {
        const int lo = a.ph_lo, hi = a.ph_hi;
#define IN(k) (((PHMASK >> (k)) & 1) && lo <= (k) && (k) < hi)
        if (IN(0) && l == 0) {
            LAUNDER();
            convert_weights(a, 0, lds, bid, G, lane, wave);
            prenorm_rows(a.x, XN, RSTD, gw, NGW, lane);
            GRID_BAR();
        }
        if (IN(1)) for (int rep_ = 0; rep_ < (((RPT_MASK >> 1) & 1) ? 2 : 1); ++rep_) {
            LAUNDER();
            pg8::SchedPlain S; S.o.init(M / 256, 2 * DFF / 256, G, bid, COLCH); S.A = (const char*)XN; S.B = (const char*)(ws + WS_W13A); S.tstepA = (size_t)256 * DM * 2; S.tstepB = (size_t)256 * DM * 2; S.nt = DM / 64;
            pg8::EpiSwiglu E{(bf16_t*)(ws + WS_ACT), DFF};
            pg8::gemm_phase<false, GSP2, GALIGN>(lds, DM, DM, S, E);
            GRID_BAR();
        }
        if (IN(2)) for (int rep_ = 0; rep_ < (((RPT_MASK >> 2) & 1) ? 2 : 1); ++rep_) {
            LAUNDER();
            pg8::SchedPlain S; S.o.init(M / 256, DM / 256, G, bid, 1); S.A = (const char*)(ws + WS_ACT); S.B = (const char*)(ws + WS_W2A); S.tstepA = (size_t)256 * DFF * 2; S.tstepB = (size_t)256 * DFF * 2; S.nt = DFF / 64;
            pg8::EpiBf16 E{(bf16_t*)(ws + WS_F_FFN), DM};
            pg8::gemm_phase<false, GSP2, GALIGN>(lds, DFF, DFF, S, E);
            GRID_BAR();
        }
        if (IN(3)) {
            LAUNDER();
            resnorm_rows((const bf16_t*)(ws + WS_F_FFN), XN, RSTD, nullptr, 0.5f, a.ffn1_norm + (size_t)(l * 2 + 1) * DM, gw, NGW, lane, ws + WS_XN8);
            GRID_BAR();
        }
        if (IN(4)) for (int rep_ = 0; rep_ < (((RPT_MASK >> 4) & 1) ? 2 : 1); ++rep_) {
            LAUNDER();
#ifndef NO_PROJ
            {
                pg8::SchedPlain S; S.o.init(M / 256, MIXIN / 256, G, bid, COLCH); S.A = (const char*)XN; S.B = (const char*)(ws + WS_WIN); S.tstepA = (size_t)256 * DM * 2; S.tstepB = (size_t)256 * DM * 2; S.nt = DM / 64;
                pg8::EpiBf16 E{(bf16_t*)(ws + WS_PROJ), MIXIN};
                pg8::gemm_phase<false, GSP2, GALIGN>(lds, DM, DM, S, E); }
#endif
#ifndef NO_G8
            {
                constexpr int NB8 = ((F8MASK >> 0) & 1) + ((F8MASK >> 1) & 1) + ((F8MASK >> 2) & 1) + ((F8MASK >> 3) & 1);
                if constexpr (NB8 > 0) {
                pg8::SchedPlain S; S.o.init(M / 256, 8 * NB8, G, bid, COLCH); S.A = (const char*)(ws + WS_XN8); S.B = (const char*)(ws + WS_WG8); S.tstepA = (size_t)256 * DM; S.tstepB = (size_t)256 * DM; S.nt = DM / 128; S.bmap = branch_list(F8MASK);
                pg8::EpiGates E{ws + WS_GATES, 1.0f / GATE_WSCALE};
                pg8::gemm_phase<true, GSP2, GALIGN>(lds, DM / 2, DM / 2, S, E); }
                if constexpr (NB8 < 4) {
                pg8::SchedPlain S; S.o.init(M / 256, 8 * (4 - NB8), G, bid, COLCH); S.A = (const char*)XN; S.B = (const char*)(ws + WS_WIN) + (size_t)MIXIN * DM * 2; S.tstepA = (size_t)256 * DM * 2; S.tstepB = (size_t)256 * DM * 2; S.nt = DM / 64; S.bmap = branch_list(~F8MASK & 15);
                pg8::EpiGates E{ws + WS_GATES, 1.0f};
                pg8::gemm_phase<false, GSP2, GALIGN>(lds, DM, DM, S, E); } }
#endif
            GRID_BAR();
        }
        if (IN(5)) for (int rep_ = 0; rep_ < (((RPT_MASK >> 5) & 1) ? 2 : 1); ++rep_) {
            LAUNDER();
            const bf16_t* proj = (const bf16_t*)(ws + WS_PROJ); bf16_t* yall = (bf16_t*)(ws + WS_YALL);
            { unsigned fq[16], vp[8];
#pragma unroll
              for (int r = 0; r < 16; ++r) { fq[r] = 0u; vp[r >> 1] = 0u; }
              for (int it = bid; it < 2048; it += G) { hgrn_a1_load(a, it, tid, fq, vp); hgrn_a1_item(lds, a, l, it, -1, fq, vp, tid, wave, lane); } }
            __syncthreads();
            for (int it = bid; it < 2048; it += G) { const int nb = 31 - (it & 31), h = (it >> 5) & 7, b = it >> 8; stickbreak_item(lds, MISC + 16, proj, yall, b, h, nb, tid, wave, lane); }
            __syncthreads();
            { WinRegs R; WinArgs W = win_args_c(a, proj, bid);
              win_fetch(W, tid, wave, lane, R);
              for (int it = bid; it < 3072; it += G) { const bool hn = it + G < 3072; const WinArgs Wn = win_args_c(a, proj, hn ? it + G : it);
                  attn_win_item(lds, W, R, hn, Wn, tid, wave, lane); W = Wn; } }
            __syncthreads();
            { WinRegs R; WinArgs W = win_args_d(a, proj, yall, l, bid);
              win_fetch(W, tid, wave, lane, R);
              for (int it = bid; it < 2048; it += G) { const bool hn = it + G < 2048; const WinArgs Wn = win_args_d(a, proj, yall, l, hn ? it + G : it);
                  attn_win_item(lds, W, R, hn, Wn, tid, wave, lane); W = Wn; } }
            GRID_BAR();
        }
        if (IN(6)) for (int rep_ = 0; rep_ < (((RPT_MASK >> 6) & 1) ? 2 : 1); ++rep_) {
            LAUNDER();
            hgrn_a2(a, gtid, gthreads);
            c_combine(a, gtid, gthreads);
            GRID_BAR();
        }
        if (IN(7)) for (int rep_ = 0; rep_ < (((RPT_MASK >> 7) & 1) ? 2 : 1); ++rep_) {
            LAUNDER();
            for (int it = bid; it < 2048; it += G) hgrn_a3_item(lds, a, l, it, tid, wave, lane);
            GRID_BAR();
        }
        if (IN(8)) for (int rep_ = 0; rep_ < (((RPT_MASK >> 8) & 1) ? 2 : 1); ++rep_) {
            LAUNDER();
            pg8::SchedBranch S; S.o.init(M / 256, DM / 256, G, bid); S.A = (const char*)(ws + WS_YALL); S.B = (const char*)(ws + WS_WBR); S.tstepA = (size_t)256 * BRT * 2; S.tstepB = (size_t)256 * BRT * 2;
            pg8::EpiBranch E{(bf16_t*)(ws + WS_MERGED), ws + WS_GATES};
            pg8::gemm_phase<false, GSP2, GALIGN>(lds, BRT, BRT, S, E);
            GRID_BAR();
        }
        if (IN(9)) for (int rep_ = 0; rep_ < (((RPT_MASK >> 9) & 1) ? 2 : 1); ++rep_) {
            LAUNDER();
            pg8::SchedPlain S; S.o.init(M / 256, DM / 256, G, bid); S.A = (const char*)(ws + WS_MERGED); S.B = (const char*)(ws + WS_WOUT); S.tstepA = (size_t)256 * DM * 2; S.tstepB = (size_t)256 * DM * 2; S.nt = DM / 64;
            pg8::EpiBf16 E{(bf16_t*)(ws + WS_F_MIX), DM};
            pg8::gemm_phase<false, GSP2, GALIGN>(lds, DM, DM, S, E);
            GRID_BAR();
        }
        if (IN(10)) {
            LAUNDER();
            resnorm_rows((const bf16_t*)(ws + WS_F_MIX), XN, RSTD, nullptr, 1.0f, a.mix_norm + (size_t)(l * 2 + 1) * DM, gw, NGW, lane);
            GRID_BAR();
        }
        if (IN(11)) for (int rep_ = 0; rep_ < (((RPT_MASK >> 11) & 1) ? 2 : 1); ++rep_) {
            LAUNDER();
            pg8::SchedPlain S; S.o.init(M / 256, 2 * DFF / 256, G, bid, COLCH); S.A = (const char*)XN; S.B = (const char*)(ws + WS_W13B); S.tstepA = (size_t)256 * DM * 2; S.tstepB = (size_t)256 * DM * 2; S.nt = DM / 64;
            pg8::EpiSwiglu E{(bf16_t*)(ws + WS_ACT), DFF};
            pg8::gemm_phase<false, GSP2, GALIGN>(lds, DM, DM, S, E);
            GRID_BAR();
        }
        if (IN(12)) for (int rep_ = 0; rep_ < (((RPT_MASK >> 12) & 1) ? 2 : 1); ++rep_) {
            LAUNDER();
            pg8::SchedPlain S; S.o.init(M / 256, DM / 256, G, bid, 1); S.A = (const char*)(ws + WS_ACT); S.B = (const char*)(ws + WS_W2B); S.tstepA = (size_t)256 * DFF * 2; S.tstepB = (size_t)256 * DFF * 2; S.nt = DFF / 64;
            pg8::EpiBf16 E{(bf16_t*)(ws + WS_F_FFN), DM};
            pg8::gemm_phase<false, GSP2, GALIGN>(lds, DFF, DFF, S, E);
            GRID_BAR();
        }
        if (IN(13)) {
            LAUNDER();
            const bool lastl = (l + 1 == DEPTH);
            resnorm_rows((const bf16_t*)(ws + WS_F_FFN), XN, RSTD, lastl ? a.out : nullptr, 0.5f, a.ffn2_norm + (size_t)(l * 2 + 1) * DM, gw, NGW, lane);
            if (!lastl) { __syncthreads(); convert_weights(a, l + 1, lds, bid, G, lane, wave); GRID_BAR(); }
        }
#undef IN
    }
}

extern "C" void kernel_launch(void* const* d_in, const int* in_sizes, int n_in, void* d_out, int out_size, void* d_ws, size_t ws_size, hipStream_t stream) {
    static int grid = 0;
    if (grid == 0) {
        if (n_in != 15 || in_sizes[0] != M * DM || out_size != M * DM || ws_size < WS_END) { fprintf(stderr, "kernel_launch: unexpected shapes (n_in %d, in0 %d, out %d, ws %zu < %zu)\n", n_in, n_in > 0 ? in_sizes[0] : -1, out_size, ws_size, (size_t)WS_END); grid = -1; return; }
        int dev = 0, cus = 0, per_cu = 0;
        if (hipGetDevice(&dev) != hipSuccess || hipDeviceGetAttribute(&cus, hipDeviceAttributeMultiprocessorCount, dev) != hipSuccess) { grid = -1; return; }
        if (hipFuncSetAttribute((const void*)fwd_kernel, hipFuncAttributeMaxDynamicSharedMemorySize, LDS_BYTES) != hipSuccess) { fprintf(stderr, "kernel_launch: hipFuncSetAttribute failed\n"); grid = -1; return; }
        if (hipOccupancyMaxActiveBlocksPerMultiprocessor(&per_cu, (const void*)fwd_kernel, 512, LDS_BYTES) != hipSuccess || per_cu < 1) fprintf(stderr, "kernel_launch: occupancy query reports %d\n", per_cu);
        (void)hipGetLastError();
        grid = cus;
    }
    if (grid < 0) return;
    if (hipMemsetAsync((char*)d_ws + WS_CTL, 0, 1 * MiB, stream) != hipSuccess) return;
    Args a{};
    a.x = (const float*)d_in[0]; a.ffn1_norm = (const float*)d_in[1]; a.ffn1_w13 = (const float*)d_in[2]; a.ffn1_w2 = (const float*)d_in[3]; a.mix_norm = (const float*)d_in[4]; a.w_in = (const float*)d_in[5];
    a.lb_logits = (const float*)d_in[6]; a.hgrn_norm = (const float*)d_in[7]; a.sinks = (const float*)d_in[8]; a.w_branch = (const float*)d_in[9]; a.w_out = (const float*)d_in[10];
    a.ffn2_norm = (const float*)d_in[11]; a.ffn2_w13 = (const float*)d_in[12]; a.ffn2_w2 = (const float*)d_in[13]; a.rel_bias = (const float*)d_in[14];
    a.out = (float*)d_out; a.ws = (unsigned char*)d_ws;
#if MK_ONE_LAUNCH
    a.l_lo = 0; a.l_hi = DEPTH; a.ph_lo = 0; a.ph_hi = NPH;
    hipLaunchKernelGGL(fwd_kernel, dim3(grid), dim3(512), LDS_BYTES, stream, a);
#else
    for (int l = 0; l < DEPTH; ++l)
        for (int p = (l == 0 ? 0 : 1); p < NPH; ++p) { a.l_lo = l; a.l_hi = l + 1; a.ph_lo = p; a.ph_hi = p + 1; hipLaunchKernelGGL(fwd_kernel, dim3(grid), dim3(512), LDS_BYTES, stream, a); }
#endif
}
```

```cpp
#include <hip/hip_runtime.h>
#include <cstdio>

#ifndef MK_ONE_LAUNCH
#define MK_ONE_LAUNCH 1
#endif
#ifndef COLCH
#define COLCH 2
#endif
#ifndef F8MASK
#define F8MASK 15
#endif
#ifndef GSP2
#define GSP2 true
#endif
#ifndef GALIGN
#define GALIGN true
#endif
#ifndef RPT_MASK
#define RPT_MASK 0
#endif
#ifndef PHMASK
#define PHMASK 0x3fff
#endif

#define LAS __attribute__((address_space(3)))
typedef unsigned short bf16_t;
typedef short bf16x8 __attribute__((ext_vector_type(8)));
typedef float f32x4 __attribute__((ext_vector_type(4)));
typedef unsigned u32x4 __attribute__((ext_vector_type(4)));
typedef unsigned u32x2 __attribute__((ext_vector_type(2)));

constexpr int DM = 2048, NBATCH = 8, SEQ = 4096, DEPTH = 4, M = NBATCH * SEQ;
constexpr int DFF = 5632, NIN = 14848, MIXIN = 6656, BRT = 1792, NGATE = 8192;
constexpr float EPS = 1e-6f;
constexpr int AQ = 0, AF = 512, AI = 1024, AG = 1536, BQ = 2048, BKo = 2560, BVo = 3072, CQ = 3584, CKo = 4352, CVo = 5120, DQo = 5888, DKo = 6400, DVo = 6528;
constexpr int NCHUNK = M / 64;

constexpr size_t MiB = 1u << 20;
constexpr size_t WS_CTL = 0;
constexpr size_t WS_W13A = 1 * MiB;
constexpr size_t WS_W2A = WS_W13A + 44 * MiB;
constexpr size_t WS_WIN = WS_W2A + 22 * MiB;
constexpr size_t WS_WBR = WS_WIN + 58 * MiB;
constexpr size_t WS_WOUT = WS_WBR + 7 * MiB;
constexpr size_t WS_W13B = WS_WOUT + 8 * MiB;
constexpr size_t WS_W2B = WS_W13B + 44 * MiB;
constexpr size_t WS_WG8 = WS_W2B + 22 * MiB;
constexpr size_t WS_XN = WS_WG8 + 16 * MiB;
constexpr size_t WS_H16 = WS_XN + 128 * MiB;
constexpr size_t WS_R = WS_H16 + 128 * MiB;
constexpr size_t WS_ACT = WS_R;
constexpr size_t WS_F_FFN = WS_R + 352 * MiB;
constexpr size_t WS_PROJ = WS_R;
constexpr size_t WS_GATES = WS_R + 416 * MiB;
constexpr size_t WS_YALL = WS_GATES + 512 * MiB;
constexpr size_t WS_QI = WS_YALL + 112 * MiB;
constexpr size_t WS_OINTRA = WS_QI + 32 * MiB;
constexpr size_t WS_SPREV = WS_OINTRA + 64 * MiB;
constexpr size_t WS_DC = WS_SPREV + 64 * MiB;
constexpr size_t WS_CPART = WS_DC + 1 * MiB;
constexpr size_t WS_CLSE = WS_CPART + 48 * MiB;
constexpr size_t WS_END = WS_CLSE + 2 * MiB;
constexpr size_t WS_U = WS_XN;
constexpr size_t WS_MERGED = WS_PROJ;
constexpr size_t WS_F_MIX = WS_GATES;
constexpr size_t WS_XN8 = WS_XN;
constexpr float GATE_WSCALE = 32.0f;
constexpr int CW_BAR = 4096;

typedef _Float16 h16x2 __attribute__((ext_vector_type(2)));
typedef _Float16 h16x8 __attribute__((ext_vector_type(8)));
__device__ __forceinline__ unsigned cvt_pk_bf16(float lo, float hi) { h16x2 v; v.x = (_Float16)lo; v.y = (_Float16)hi; return __builtin_bit_cast(unsigned, v); }
__device__ __forceinline__ bf16_t f2bf(float f) { return __builtin_bit_cast(unsigned short, (_Float16)f); }
__device__ __forceinline__ float bf2f(bf16_t b) { return (float)__builtin_bit_cast(_Float16, b); }
__device__ __forceinline__ float bflo(unsigned w) { return (float)__builtin_bit_cast(h16x2, w).x; }
__device__ __forceinline__ float bfhi(unsigned w) { return (float)__builtin_bit_cast(h16x2, w).y; }
#define MFMA16(a, b, c) __builtin_amdgcn_mfma_f32_16x16x32_f16(__builtin_bit_cast(h16x8, (a)), __builtin_bit_cast(h16x8, (b)), (c), 0, 0, 0)
__device__ __forceinline__ unsigned cvt_pk_b16(float lo, float hi) { unsigned r; asm volatile("v_cvt_pk_bf16_f32 %0, %1, %2" : "=v"(r) : "v"(lo), "v"(hi)); return r; }
__device__ __forceinline__ bf16_t f2b16(float f) { return (bf16_t)(cvt_pk_b16(f, 0.f) & 0xffffu); }
__device__ __forceinline__ float b16lo(unsigned w) { return __uint_as_float(w << 16); }
__device__ __forceinline__ float b16hi(unsigned w) { return __uint_as_float(w & 0xffff0000u); }
#define MFMAB(a, b, c) __builtin_amdgcn_mfma_f32_16x16x32_bf16((a), (b), (c), 0, 0, 0)
typedef int v8i32 __attribute__((ext_vector_type(8)));
typedef int v4i32 __attribute__((ext_vector_type(4)));
__device__ __forceinline__ unsigned pk_fp8x4(float a, float b, float c, float d) { int w = __builtin_amdgcn_cvt_pk_fp8_f32(a, b, 0, false); w = __builtin_amdgcn_cvt_pk_fp8_f32(c, d, w, true); return (unsigned)w; }
__device__ __forceinline__ f32x4 mfma_fp8(const bf16x8 a0, const bf16x8 a1, const bf16x8 b0, const bf16x8 b1, const f32x4 c) {
    const u32x4 x0 = __builtin_bit_cast(u32x4, a0), x1 = __builtin_bit_cast(u32x4, a1), y0 = __builtin_bit_cast(u32x4, b0), y1 = __builtin_bit_cast(u32x4, b1);
    const v8i32 A = {(int)x0.x, (int)x0.y, (int)x0.z, (int)x0.w, (int)x1.x, (int)x1.y, (int)x1.z, (int)x1.w}, B = {(int)y0.x, (int)y0.y, (int)y0.z, (int)y0.w, (int)y1.x, (int)y1.y, (int)y1.z, (int)y1.w};
    return __builtin_amdgcn_mfma_scale_f32_16x16x128_f8f6f4(A, B, c, 0, 0, 0, 0x7f7f7f7f, 0, 0x7f7f7f7f);
}
__device__ __forceinline__ float wave_sum(float v) {
#pragma unroll
    for (int o = 1; o < 64; o <<= 1) v += __shfl_xor(v, o);
    return v;
}
__device__ __forceinline__ float fast_sigmoid(float x) { return __builtin_amdgcn_rcpf(1.0f + __expf(-x)); }
#define LDS_WAIT() asm volatile("s_waitcnt lgkmcnt(0)" ::: "memory")
template <int CTRL> __device__ __forceinline__ float dpp_f(float x) { return __builtin_bit_cast(float, __builtin_amdgcn_update_dpp(0, __builtin_bit_cast(int, x), CTRL, 0xf, 0xf, true)); }
__device__ __forceinline__ float row16_max(float v) { v = fmaxf(v, dpp_f<0xB1>(v)); v = fmaxf(v, dpp_f<0x4E>(v)); v = fmaxf(v, dpp_f<0x141>(v)); v = fmaxf(v, dpp_f<0x140>(v)); return v; }
__device__ __forceinline__ float row16_sum(float v) { v += dpp_f<0xB1>(v); v += dpp_f<0x4E>(v); v += dpp_f<0x141>(v); v += dpp_f<0x140>(v); return v; }

template <int TOFF> __device__ __forceinline__ void tr_frag4(unsigned addr, bf16x8 (&v)[4]) {
    u32x2 a0, a1, b0, b1, c0, c1, d0, d1;
    asm volatile("ds_read_b64_tr_b16 %0, %8\n\tds_read_b64_tr_b16 %1, %8 offset:%9\n\tds_read_b64_tr_b16 %2, %8 offset:32\n\tds_read_b64_tr_b16 %3, %8 offset:%10\n\t"
                 "ds_read_b64_tr_b16 %4, %8 offset:64\n\tds_read_b64_tr_b16 %5, %8 offset:%11\n\tds_read_b64_tr_b16 %6, %8 offset:96\n\tds_read_b64_tr_b16 %7, %8 offset:%12\n\ts_waitcnt lgkmcnt(0)"
                 : "=&v"(a0), "=&v"(a1), "=&v"(b0), "=&v"(b1), "=&v"(c0), "=&v"(c1), "=&v"(d0), "=&v"(d1) : "v"(addr), "n"(TOFF), "n"(TOFF + 32), "n"(TOFF + 64), "n"(TOFF + 96) : "memory");
    v[0] = __builtin_bit_cast(bf16x8, (u32x4){a0.x, a0.y, a1.x, a1.y}); v[1] = __builtin_bit_cast(bf16x8, (u32x4){b0.x, b0.y, b1.x, b1.y});
    v[2] = __builtin_bit_cast(bf16x8, (u32x4){c0.x, c0.y, c1.x, c1.y}); v[3] = __builtin_bit_cast(bf16x8, (u32x4){d0.x, d0.y, d1.x, d1.y});
}
__device__ __forceinline__ unsigned lds_addr(const LAS void* p) { return (unsigned)(size_t)p; }

#define XB_TMO      128
#define XB_XCNT(j)  (256  + 64 * (j))
#define XB_XSUB(j)  (1280 + 64 * (j))
#define XB_XGEN(j)  (2304 + 64 * (j))
#define XB_TOP      3328
#define XB_TOPGEN   3392
#define XCD_BAR_WORDS 3456
#define XB_SPIN_CAP (1u << 18)

__device__ __forceinline__ unsigned xb_ld(unsigned* p)              { return __hip_atomic_load(p, __ATOMIC_RELAXED, __HIP_MEMORY_SCOPE_AGENT); }
__device__ __forceinline__ unsigned xb_add(unsigned* p, unsigned v) { return __hip_atomic_fetch_add(p, v, __ATOMIC_RELAXED, __HIP_MEMORY_SCOPE_AGENT); }
__device__ __forceinline__ unsigned xb_xcc_id() { return (unsigned)__builtin_amdgcn_s_getreg((3 << 11) | 20) & 0xFu; }
#define XB_SPIN(cond, bar) do { unsigned _sp = 0; while (cond) { __builtin_amdgcn_s_sleep(1); \
    if ((++_sp & 255u) == 0u) { if (xb_ld(&(bar)[XB_TMO])) break; if (_sp > XB_SPIN_CAP) { atomicAdd(&(bar)[XB_TMO], 1u); break; } } } } while (0)

struct XcdBarrier { unsigned* bar; unsigned x; volatile LAS unsigned* st; };

__device__ __forceinline__ XcdBarrier xcd_barrier_post(unsigned* bar, volatile LAS unsigned* st) {
    XcdBarrier b; b.bar = bar; b.x = xb_xcc_id(); b.st = st;
    if (threadIdx.x == 0) (void)xb_add(&bar[XB_XCNT(b.x)], 1u);
    return b;
}
__device__ __forceinline__ void xcd_barrier_complete(unsigned* bar, unsigned x, unsigned& nloc, unsigned& nx) {
    const unsigned G = gridDim.x * gridDim.y * gridDim.z;
    unsigned sum, cnt, mine, sp = 0u;
    for (;;) {
        sum = 0u; cnt = 0u; mine = 0u;
#pragma unroll
        for (unsigned j = 0; j < 16; ++j) { const unsigned c = xb_ld(&bar[XB_XCNT(j)]); sum += c; cnt += (c > 0u) ? 1u : 0u; mine = (j == x) ? c : mine; }
        if (sum == G) break;
        __builtin_amdgcn_s_sleep(1);
        if ((++sp & 255u) == 0u) { if (xb_ld(&bar[XB_TMO])) break; if (sp > XB_SPIN_CAP) { atomicAdd(&bar[XB_TMO], 1u); break; } }
    }
    nloc = mine > 0u ? mine : 1u; nx = cnt > 0u ? cnt : 1u;
}
__device__ __forceinline__ void xcd_barrier(const XcdBarrier& b) {
    asm volatile("s_waitcnt vmcnt(0)" ::: "memory");
    __syncthreads();
    if (threadIdx.x == 0) {
        unsigned* bar = b.bar;
        __builtin_amdgcn_s_waitcnt(0);
        unsigned nloc = b.st[0], nx = b.st[1];
        if (nloc == 0u) { xcd_barrier_complete(bar, b.x, nloc, nx); b.st[0] = nloc; b.st[1] = nx; }
        const unsigned old = xb_add(&bar[XB_XSUB(b.x)], 1u);
        const unsigned gen = old / nloc;
        if (old + 1u == (gen + 1u) * nloc) {
            __builtin_amdgcn_fence(__ATOMIC_RELEASE, "agent");
            asm volatile("s_waitcnt vmcnt(0)" ::: "memory");
            const unsigned og = xb_add(&bar[XB_TOP], 1u);
            const unsigned tg = og / nx;
            if (og + 1u == (tg + 1u) * nx) xb_add(&bar[XB_TOPGEN], 1u);
            else XB_SPIN(xb_ld(&bar[XB_TOPGEN]) == tg, bar);
            __builtin_amdgcn_fence(__ATOMIC_ACQUIRE, "agent");
            xb_add(&bar[XB_XGEN(b.x)], 1u);
            asm volatile("s_waitcnt vmcnt(0)" ::: "memory");
        } else {
            XB_SPIN(xb_ld(&bar[XB_XGEN(b.x)]) == gen, bar);
            __builtin_amdgcn_fence(__ATOMIC_ACQUIRE, "agent");
            asm volatile("s_waitcnt vmcnt(0)" ::: "memory");
        }
    }
    __syncthreads();
}

namespace pg8 {
constexpr int BM = 256, BK = 64, HALF = 128, HTB = HALF * BK * 2, STAGE_BYTES = 8 * HTB, NXCD = 8, WGM = 4;
__device__ __forceinline__ int lds_byte(int r, int c) { const int st = (r >> 4) * 2 + (c >> 5), rr = r & 15, cc = c & 31, ob = rr * 64 + cc * 2; return st * 1024 + (ob ^ (((ob >> 9) & 1) << 5)); }
__device__ __forceinline__ void stage_rc(int b, int& R, int& C) { const int st = b / 1024, sb = b % 1024, swz = sb ^ (((sb >> 9) & 1) << 5); R = (st >> 1) * 16 + swz / 64; C = (st & 1) * 32 + (swz % 64) / 2; }
__device__ __forceinline__ int perm32(int rho) { const int n = rho >> 4, i = rho & 15; return 8 * (i >> 2) + 4 * n + (i & 3); }

struct Unit { int pm, pn, aux, nt; const char* A; const char* B; };

struct TileOrder {
    int nM, nN, nwg, G, c, rev;
    __device__ __forceinline__ void init(int nM_, int nN_, int G_, int c_, int rev_ = 0) { nM = nM_; nN = nN_; nwg = nM * nN; G = G_; c = c_; rev = rev_; }
    __device__ __forceinline__ bool tile(int i, int& pm, int& pn) const {
        const long L = (long)i * G + c; if (L >= nwg) return false;
        int wgid = (int)L; { const int q = nwg / NXCD, r = nwg % NXCD, xcd = wgid % NXCD; int off = wgid / NXCD; if ((rev & 1) && r == 0) off = q - 1 - off;
            wgid = (xcd < r ? xcd * (q + 1) : r * (q + 1) + (xcd - r) * q) + off; }
        if (rev & 2) {
            const int nig = WGM * nM, gid = wgid / nig, fn = gid * WGM, gsz = (nN - fn) < WGM ? (nN - fn) : WGM;
            pn = fn + ((wgid % nig) % gsz); pm = (wgid % nig) / gsz; return true; }
        const int nig = WGM * nN, gid = wgid / nig, fm = gid * WGM, gsz = (nM - fm) < WGM ? (nM - fm) : WGM;
        pm = fm + ((wgid % nig) % gsz); pn = (wgid % nig) / gsz; return true;
    }
};
struct SchedPlain {
    TileOrder o; const char* A; const char* B; size_t tstepA, tstepB; int nt; int bmap = -1;
    __device__ __forceinline__ bool next(int i, Unit& u) const {
        if (!o.tile(i, u.pm, u.pn)) return false;
        if (bmap >= 0) u.pn = 8 * ((bmap >> (4 * (u.pn >> 3))) & 15) + (u.pn & 7);
        u.A = A + (size_t)u.pm * tstepA; u.B = B + (size_t)u.pn * tstepB; u.nt = nt; u.aux = 0; return true;
    }
};
struct SchedBranch {
    TileOrder o; const char* A; const char* B; size_t tstepA, tstepB;
    __device__ __forceinline__ bool next(int i, Unit& u) const {
        if (!o.tile(i >> 2, u.pm, u.pn)) return false;
        const int br = i & 3; const int koff = br == 0 ? 0 : (br == 1 ? 512 : (br == 2 ? 1024 : 1280));
        u.A = A + (size_t)u.pm * tstepA + (size_t)koff * 2; u.B = B + (size_t)u.pn * tstepB + (size_t)koff * 2; u.nt = (br == 2) ? 4 : 8; u.aux = br; return true;
    }
};

struct EpiBf16 {
    bf16_t* O; int ldc;
    __device__ __forceinline__ bool operator()(f32x4 (&acc)[2][2][4][2], const Unit& u, int wr, int wc, int fr, int fq) const {
        const int row0 = u.pm * BM + wr * 64 + fr, col0 = u.pn * BM + wc * 32 + 8 * fq;
#pragma unroll
        for (int ai = 0; ai < 2; ++ai)
#pragma unroll
            for (int m = 0; m < 4; ++m) { bf16_t* rowp = O + (size_t)(row0 + ai * HALF + m * 16) * ldc + col0;
#pragma unroll
                for (int bj = 0; bj < 2; ++bj) { const f32x4 v0 = acc[ai][bj][m][0], v1 = acc[ai][bj][m][1];
                    u32x4 w; w.x = cvt_pk_bf16(v0[0], v0[1]); w.y = cvt_pk_bf16(v0[2], v0[3]); w.z = cvt_pk_bf16(v1[0], v1[1]); w.w = cvt_pk_bf16(v1[2], v1[3]);
                    *(u32x4*)(rowp + bj * HALF) = w; } }
        return true;
    }
};
struct EpiSwiglu {
    bf16_t* O; int ldc;
    __device__ __forceinline__ bool operator()(f32x4 (&acc)[2][2][4][2], const Unit& u, int wr, int wc, int fr, int fq) const {
        typedef float f32x2 __attribute__((ext_vector_type(2)));
        const int row0 = u.pm * BM + wr * 64 + fr, col0 = u.pn * HALF + wc * 32 + 8 * fq;
#pragma unroll
        for (int ai = 0; ai < 2; ++ai)
#pragma unroll
            for (int m = 0; m < 4; ++m) { bf16_t* rowp = O + (size_t)(row0 + ai * HALF + m * 16) * ldc + col0;
                unsigned w[4];
#pragma unroll
                for (int n = 0; n < 2; ++n)
#pragma unroll
                    for (int jp = 0; jp < 2; ++jp) { const f32x2 g = {acc[ai][0][m][n][2 * jp], acc[ai][0][m][n][2 * jp + 1]}, up = {acc[ai][1][m][n][2 * jp], acc[ai][1][m][n][2 * jp + 1]};
                        f32x2 e; e.x = __builtin_amdgcn_exp2f(g.x); e.y = __builtin_amdgcn_exp2f(g.y);
                        const f32x2 d = e + 1.0f; f32x2 r; r.x = __builtin_amdgcn_rcpf(d.x); r.y = __builtin_amdgcn_rcpf(d.y);
                        const f32x2 h = (g * up) * r; w[n * 2 + jp] = cvt_pk_b16(h.x, h.y); }
                *(u32x4*)rowp = (u32x4){w[0], w[1], w[2], w[3]}; }
        return true;
    }
};
struct EpiInproj {
    bf16_t* P; bf16_t* Gt;
    __device__ __forceinline__ bool operator()(f32x4 (&acc)[2][2][4][2], const Unit& u, int wr, int wc, int fr, int fq) const {
        const int row0 = u.pm * BM + wr * 64 + fr; const bool isg = u.pn >= 26;
        bf16_t* base = isg ? Gt : P; const int ldc = isg ? NGATE : MIXIN; const int col0 = (isg ? (u.pn - 26) : u.pn) * BM + wc * 32 + 8 * fq;
#pragma unroll
        for (int ai = 0; ai < 2; ++ai)
#pragma unroll
            for (int m = 0; m < 4; ++m) { bf16_t* rowp = base + (size_t)(row0 + ai * HALF + m * 16) * ldc + col0;
#pragma unroll
                for (int bj = 0; bj < 2; ++bj) { f32x4 v0 = acc[ai][bj][m][0], v1 = acc[ai][bj][m][1];
                    if (isg) {
#pragma unroll
                        for (int j = 0; j < 4; ++j) { v0[j] = fminf(1.0f + __expf(-v0[j]), 60000.0f); v1[j] = fminf(1.0f + __expf(-v1[j]), 60000.0f); } }
                    u32x4 w; w.x = cvt_pk_bf16(v0[0], v0[1]); w.y = cvt_pk_bf16(v0[2], v0[3]); w.z = cvt_pk_bf16(v1[0], v1[1]); w.w = cvt_pk_bf16(v1[2], v1[3]);
                    *(u32x4*)(rowp + bj * HALF) = w; } }
        return true;
    }
};
struct EpiGates {
    unsigned char* Gt; float inv;
    __device__ __forceinline__ bool operator()(f32x4 (&acc)[2][2][4][2], const Unit& u, int wr, int wc, int fr, int fq) const {
        const int row0 = u.pm * BM + wr * 64 + fr, col0 = u.pn * BM + wc * 32 + 8 * fq; const float ninv2 = -inv * 1.44269504089f;
#pragma unroll
        for (int ai = 0; ai < 2; ++ai)
#pragma unroll
            for (int m = 0; m < 4; ++m) { unsigned char* rowp = Gt + (size_t)(row0 + ai * HALF + m * 16) * NGATE + col0;
#pragma unroll
                for (int bj = 0; bj < 2; ++bj) { const f32x4 v0 = acc[ai][bj][m][0] * ninv2, v1 = acc[ai][bj][m][1] * ninv2;
                    f32x4 e0, e1;
#pragma unroll
                    for (int j = 0; j < 4; ++j) { e0[j] = fminf(__builtin_amdgcn_exp2f(v0[j]), 500.0f); e1[j] = fminf(__builtin_amdgcn_exp2f(v1[j]), 500.0f); }
                    e0 = e0 + 1.0f; e1 = e1 + 1.0f;
                    f32x4 g0, g1;
#pragma unroll
                    for (int j = 0; j < 4; ++j) { g0[j] = __builtin_amdgcn_rcpf(e0[j]); g1[j] = __builtin_amdgcn_rcpf(e1[j]); }
                    g0 = g0 * 255.0f; g1 = g1 * 255.0f;
                    unsigned w0 = 0u, w1 = 0u;
#pragma unroll
                    for (int j = 0; j < 4; ++j) { w0 = __builtin_amdgcn_cvt_pk_u8_f32(__builtin_rintf(g0[j]), j, w0); w1 = __builtin_amdgcn_cvt_pk_u8_f32(__builtin_rintf(g1[j]), j, w1); }
                    *(u32x2*)(rowp + bj * HALF) = (u32x2){w0, w1}; } }
        return true;
    }
};
struct EpiBranch {
    bf16_t* Mg; const unsigned char* Gt;
    __device__ __forceinline__ void apply(f32x4 (&acc)[2][2][4][2], int ai, int m, int bj, const u32x2 c8, const u32x2 n8, int br, size_t off) const {
        f32x4 v0 = acc[ai][bj][m][0], v1 = acc[ai][bj][m][1];
#define UB(w, k) ((float)(((w) >> (8 * (k))) & 0xffu))
        v0[0] *= UB(c8.x, 0) * __builtin_amdgcn_rcpf(UB(n8.x, 0)); v0[1] *= UB(c8.x, 1) * __builtin_amdgcn_rcpf(UB(n8.x, 1));
        v0[2] *= UB(c8.x, 2) * __builtin_amdgcn_rcpf(UB(n8.x, 2)); v0[3] *= UB(c8.x, 3) * __builtin_amdgcn_rcpf(UB(n8.x, 3));
        v1[0] *= UB(c8.y, 0) * __builtin_amdgcn_rcpf(UB(n8.y, 0)); v1[1] *= UB(c8.y, 1) * __builtin_amdgcn_rcpf(UB(n8.y, 1));
        v1[2] *= UB(c8.y, 2) * __builtin_amdgcn_rcpf(UB(n8.y, 2)); v1[3] *= UB(c8.y, 3) * __builtin_amdgcn_rcpf(UB(n8.y, 3));
#undef UB
        if (br < 3) { acc[ai][bj][m][0] = v0; acc[ai][bj][m][1] = v1; }
        else { u32x4 w; w.x = cvt_pk_b16(v0[0], v0[1]); w.y = cvt_pk_b16(v0[2], v0[3]); w.z = cvt_pk_b16(v1[0], v1[1]); w.w = cvt_pk_b16(v1[2], v1[3]); *(u32x4*)(Mg + off) = w; }
    }
    __device__ __forceinline__ bool operator()(f32x4 (&acc)[2][2][4][2], const Unit& u, int wr, int wc, int fr, int fq) const {
        const int row0 = u.pm * BM + wr * 64 + fr, col0 = u.pn * BM + wc * 32 + 8 * fq; const int br = u.aux;
        const u32x2 one = (u32x2){0xffffffffu, 0xffffffffu};
        u32x2 ec[3][2], en[3][2];
#define EB_LOAD(buf, q) do { _Pragma("unroll") for (int bj = 0; bj < 2; ++bj) { \
            const unsigned char* gp = Gt + (size_t)(row0 + ((q) >> 2) * HALF + ((q) & 3) * 16) * NGATE + (size_t)br * DM + col0 + bj * HALF; \
            ec[buf][bj] = *(const u32x2*)gp; en[buf][bj] = one; if (br < 3) en[buf][bj] = *(const u32x2*)(gp + DM); } } while (0)
#define EB_APPLY(buf, q) do { _Pragma("unroll") for (int bj = 0; bj < 2; ++bj) \
            apply(acc, (q) >> 2, (q) & 3, bj, ec[buf][bj], en[buf][bj], br, (size_t)(row0 + ((q) >> 2) * HALF + ((q) & 3) * 16) * DM + col0 + bj * HALF); } while (0)
        EB_LOAD(0, 0); asm volatile("" ::: "memory");
        EB_LOAD(1, 1); asm volatile("" ::: "memory");
        EB_LOAD(2, 2); asm volatile("" ::: "memory");
        EB_APPLY(0, 0); asm volatile("" ::: "memory"); EB_LOAD(0, 3); asm volatile("" ::: "memory");
        EB_APPLY(1, 1); asm volatile("" ::: "memory"); EB_LOAD(1, 4); asm volatile("" ::: "memory");
        EB_APPLY(2, 2); asm volatile("" ::: "memory"); EB_LOAD(2, 5); asm volatile("" ::: "memory");
        EB_APPLY(0, 3); asm volatile("" ::: "memory"); EB_LOAD(0, 6); asm volatile("" ::: "memory");
        EB_APPLY(1, 4); asm volatile("" ::: "memory"); EB_LOAD(1, 7); asm volatile("" ::: "memory");
        EB_APPLY(2, 5); asm volatile("" ::: "memory");
        EB_APPLY(0, 6); asm volatile("" ::: "memory");
        EB_APPLY(1, 7); asm volatile("" ::: "memory");
#undef EB_LOAD
#undef EB_APPLY
        return br == 3;
    }
};

template <bool F8 = false, bool SP2 = false, bool ALIGN = false, class Epi, class Sched>
__device__ __forceinline__ void gemm_phase(LAS unsigned char* lds, const int lda, const int ldb, const Sched& S, const Epi& E) {
    int tid_ = threadIdx.x; asm volatile("" : "+v"(tid_));
    const int tid = tid_, wid = __builtin_amdgcn_readfirstlane(tid >> 6), lane = tid & 63, wr = wid >> 2, wc = wid & 3, fr = lane & 15, fq = lane >> 4;
    unsigned voffA[2], voffB[2];
#pragma unroll
    for (int i = 0; i < 2; ++i) { int R, C; stage_rc(tid * 16 + i * 8192, R, C); const int Rb = (R & ~31) + perm32(R & 31);
        voffA[i] = (unsigned)(R * lda + C) * 2u; voffB[i] = (unsigned)(Rb * ldb + C) * 2u; }
    const size_t kstep = (size_t)(BK * 2);
    const size_t hstepA = (size_t)HALF * lda * 2, hstepB = (size_t)HALF * ldb * 2;
    const unsigned ldsw = (unsigned)wid * 1024u;
    const int aoff = lds_byte(wr * 64 + fr, fq * 8), boff = lds_byte(wc * 32 + fr, fq * 8);
#define PG8_SA(b, h) (((b) * 2 + (h)) * HTB)
#define PG8_SB(b, h) ((4 + (b) * 2 + (h)) * HTB)
#define PG8_STAGE(bufoff, gbase, voff) do { _Pragma("unroll") for (int _i = 0; _i < 2; ++_i) \
        __builtin_amdgcn_global_load_lds((const unsigned*)((const char*)(gbase) + (voff)[_i]), (LAS unsigned*)(lds + (bufoff) + ldsw + _i * 8192), 16, 0, 0); } while (0)
#define PG8_LDA(dst, b, h) do { if constexpr (F8) { _Pragma("unroll") for (int m = 0; m < 4; ++m) { A8[m].lo = *(const LAS v4i32*)(lds + PG8_SA(b, h) + aoff + m * 2048); A8[m].hi = *(const LAS v4i32*)(lds + PG8_SA(b, h) + aoff + m * 2048 + 1024); } } \
        else { _Pragma("unroll") for (int m = 0; m < 4; ++m) _Pragma("unroll") for (int k = 0; k < 2; ++k) dst[m][k] = *(const LAS bf16x8*)(lds + PG8_SA(b, h) + aoff + m * 2048 + k * 1024); } } while (0)
#define PG8_LDB(dst, b, h) do { if constexpr (F8) { _Pragma("unroll") for (int n = 0; n < 2; ++n) { dst##8[n].lo = *(const LAS v4i32*)(lds + PG8_SB(b, h) + boff + n * 2048); dst##8[n].hi = *(const LAS v4i32*)(lds + PG8_SB(b, h) + boff + n * 2048 + 1024); } } \
        else { _Pragma("unroll") for (int n = 0; n < 2; ++n) _Pragma("unroll") for (int k = 0; k < 2; ++k) dst[n][k] = *(const LAS bf16x8*)(lds + PG8_SB(b, h) + boff + n * 2048 + k * 1024); } } while (0)
#define PG8_MMA(ai, bj, At, Bt) do { __builtin_amdgcn_s_setprio(1); _Pragma("unroll") for (int m = 0; m < 4; ++m) _Pragma("unroll") for (int n = 0; n < 2; ++n) { \
        if constexpr (F8) asm volatile("v_mfma_scale_f32_16x16x128_f8f6f4 %0, %1, %2, %0, %3, %3 op_sel_hi:[0,0,0]" : "+v"(acc[ai][bj][m][n]) : "v"(Bt##8[n]), "v"(A8[m]), "v"(sc8)); \
        else { _Pragma("unroll") for (int k = 0; k < 2; ++k) acc[ai][bj][m][n] = MFMAB(Bt[n][k], At[m][k], acc[ai][bj][m][n]); } } __builtin_amdgcn_s_setprio(0); } while (0)
#define PG8_WAIT_V(n) asm volatile("s_waitcnt vmcnt(" #n ")" ::: "memory")
#define PG8_WAIT_L(n) asm volatile("s_waitcnt lgkmcnt(" #n ")" ::: "memory")
#define PG8_BAR __builtin_amdgcn_s_barrier()
#define PG8_SCHED __builtin_amdgcn_sched_barrier(0)
    Unit cur, nxt; int ui = 0;
    if (!S.next(0, cur)) return;
    f32x4 acc[2][2][4][2];
#pragma unroll
    for (int a = 0; a < 2; ++a)
#pragma unroll
        for (int b = 0; b < 2; ++b)
#pragma unroll
            for (int m = 0; m < 4; ++m)
#pragma unroll
                for (int n = 0; n < 2; ++n) acc[a][b][m][n] = (f32x4){0.f, 0.f, 0.f, 0.f};
    bf16x8 At[4][2], B0[2][2], B1[2][2];
    v8i32 A8[4], B08[2], B18[2];
    const int sc8 = 0x7f7f7f7f;
    const char* cA = cur.A; const char* cB = cur.B; int nt = cur.nt;
    if constexpr (SP2) {
        PG8_STAGE(PG8_SB(0, 0), cB, voffB); PG8_STAGE(PG8_SB(0, 1), cB + hstepB, voffB); PG8_STAGE(PG8_SA(0, 0), cA, voffA); PG8_STAGE(PG8_SA(0, 1), cA + hstepA, voffA);
        if (wr == 1) PG8_BAR;
        PG8_WAIT_V(2); PG8_BAR;
        PG8_STAGE(PG8_SB(1, 0), cB + kstep, voffB); PG8_STAGE(PG8_SA(1, 0), cA + kstep, voffA); PG8_STAGE(PG8_SB(1, 1), cB + hstepB + kstep, voffB);
        PG8_WAIT_V(6); PG8_BAR;
    } else {
    PG8_STAGE(PG8_SB(0, 0), cB, voffB); PG8_STAGE(PG8_SA(0, 0), cA, voffA); PG8_STAGE(PG8_SB(0, 1), cB + hstepB, voffB); PG8_STAGE(PG8_SA(0, 1), cA + hstepA, voffA);
    if (wr == 1) PG8_BAR;
    PG8_WAIT_V(4); PG8_BAR;
    PG8_STAGE(PG8_SB(1, 0), cB + kstep, voffB); PG8_STAGE(PG8_SA(1, 0), cA + kstep, voffA); PG8_STAGE(PG8_SB(1, 1), cB + hstepB + kstep, voffB);
    PG8_WAIT_V(6); PG8_BAR;
    }
    for (;;) {
        const bool has_next = S.next(ui + 1, nxt);
        const char* nA = has_next ? nxt.A : cA; const char* nB = has_next ? nxt.B : cB;
        for (int t = 0; t < nt; t += 2) {
            const bool last = (t == nt - 2);
            const char* a1 = cA + (size_t)(t + 1) * kstep;
            const char* a2 = last ? nA : cA + (size_t)(t + 2) * kstep; const char* b2 = last ? nB : cB + (size_t)(t + 2) * kstep;
            const char* a3 = a2 + kstep; const char* b3 = b2 + kstep;
            if constexpr (SP2) {
            PG8_LDB(B0, 0, 0); PG8_LDB(B1, 0, 1); PG8_SCHED; PG8_LDA(At, 0, 0); PG8_STAGE(PG8_SA(1, 1), a1 + hstepA, voffA);
            PG8_WAIT_V(8); PG8_WAIT_L(0); PG8_BAR; PG8_MMA(0, 0, At, B0); PG8_MMA(0, 1, At, B1); PG8_BAR; PG8_SCHED;
            PG8_LDA(At, 0, 1); PG8_STAGE(PG8_SB(0, 0), b2, voffB); PG8_STAGE(PG8_SB(0, 1), b2 + hstepB, voffB); PG8_STAGE(PG8_SA(0, 0), a2, voffA);
            PG8_WAIT_V(8); PG8_WAIT_L(0); PG8_BAR; PG8_MMA(1, 0, At, B0); PG8_MMA(1, 1, At, B1); PG8_BAR; PG8_SCHED;
            PG8_LDB(B0, 1, 0); PG8_LDB(B1, 1, 1); PG8_SCHED; PG8_LDA(At, 1, 0); PG8_STAGE(PG8_SA(0, 1), a2 + hstepA, voffA);
            PG8_WAIT_V(8); PG8_WAIT_L(0); PG8_BAR; PG8_MMA(0, 0, At, B0); PG8_MMA(0, 1, At, B1); PG8_BAR; PG8_SCHED;
            PG8_LDA(At, 1, 1); PG8_STAGE(PG8_SB(1, 0), b3, voffB); PG8_STAGE(PG8_SB(1, 1), b3 + hstepB, voffB); PG8_STAGE(PG8_SA(1, 0), a3, voffA);
            PG8_WAIT_V(8); PG8_WAIT_L(0); PG8_BAR; PG8_MMA(1, 0, At, B0); PG8_MMA(1, 1, At, B1); PG8_BAR; PG8_SCHED;
            } else {
            PG8_LDB(B0, 0, 0); PG8_SCHED; PG8_LDA(At, 0, 0); PG8_STAGE(PG8_SA(1, 1), a1 + hstepA, voffA);
            PG8_WAIT_L(8); PG8_BAR; PG8_WAIT_L(0); PG8_MMA(0, 0, At, B0); PG8_BAR; PG8_SCHED;
            PG8_LDB(B1, 0, 1); PG8_STAGE(PG8_SB(0, 0), b2, voffB);
            PG8_BAR; PG8_WAIT_L(0); PG8_MMA(0, 1, At, B1); PG8_BAR;
            PG8_LDA(At, 0, 1); PG8_STAGE(PG8_SA(0, 0), a2, voffA);
            PG8_BAR; PG8_WAIT_L(0); PG8_MMA(1, 0, At, B0); PG8_BAR; PG8_SCHED;
            PG8_STAGE(PG8_SB(0, 1), b2 + hstepB, voffB);
            PG8_WAIT_V(6); PG8_BAR; PG8_MMA(1, 1, At, B1); PG8_BAR;
            PG8_LDB(B0, 1, 0); PG8_SCHED; PG8_LDA(At, 1, 0); PG8_STAGE(PG8_SA(0, 1), a2 + hstepA, voffA);
            PG8_WAIT_L(8); PG8_BAR; PG8_WAIT_L(0); PG8_MMA(0, 0, At, B0); PG8_BAR; PG8_SCHED;
            PG8_LDB(B1, 1, 1); PG8_STAGE(PG8_SB(1, 0), b3, voffB);
            PG8_BAR; PG8_WAIT_L(0); PG8_MMA(0, 1, At, B1); PG8_BAR;
            PG8_LDA(At, 1, 1); PG8_STAGE(PG8_SA(1, 0), a3, voffA);
            PG8_BAR; PG8_WAIT_L(0); PG8_MMA(1, 0, At, B0); PG8_BAR; PG8_SCHED;
            PG8_STAGE(PG8_SB(1, 1), b3 + hstepB, voffB);
            PG8_WAIT_V(6); PG8_BAR; PG8_MMA(1, 1, At, B1); PG8_BAR;
            }
        }
        if constexpr (ALIGN) { if (wr == 0) PG8_BAR; }
        const bool consumed = E(acc, cur, wr, wc, fr, fq);
        if (!has_next) break;
        if (consumed)
#pragma unroll
        for (int a = 0; a < 2; ++a)
#pragma unroll
            for (int b = 0; b < 2; ++b)
#pragma unroll
                for (int m = 0; m < 4; ++m)
#pragma unroll
                    for (int n = 0; n < 2; ++n) acc[a][b][m][n] = (f32x4){0.f, 0.f, 0.f, 0.f};
        cur = nxt; cA = nA; cB = nB; nt = cur.nt; ++ui;
        if constexpr (ALIGN) { if (wr == 1) PG8_BAR; }
    }
    PG8_WAIT_V(0);
    if constexpr (!ALIGN) { if (wr == 0) PG8_BAR; }
    PG8_BAR;
#undef PG8_SA
#undef PG8_SB
#undef PG8_STAGE
#undef PG8_LDA
#undef PG8_LDB
#undef PG8_MMA
#undef PG8_WAIT_V
#undef PG8_WAIT_L
#undef PG8_BAR
#undef PG8_SCHED
}
}

constexpr int branch_list(int mask) { int r = 0, n = 0; for (int b = 0; b < 4; ++b) if ((mask >> b) & 1) { r |= b << (4 * n); ++n; } return r; }
struct Args {
    const float* x; const float* ffn1_norm; const float* ffn1_w13; const float* ffn1_w2; const float* mix_norm; const float* w_in; const float* lb_logits; const float* hgrn_norm;
    const float* sinks; const float* w_branch; const float* w_out; const float* ffn2_norm; const float* ffn2_w13; const float* ffn2_w2; const float* rel_bias;
    float* out; unsigned char* ws;
    int l_lo, l_hi, ph_lo, ph_hi;
};

struct ConvDesc { const float* W; const float* gk; bf16_t* WT; unsigned char* W8; int K, N, k0, n0, drow0; float wscale; };
__device__ __forceinline__ ConvDesc conv_desc(const Args& a, int l, int it) {
    unsigned char* ws = a.ws;
    constexpr int I13 = (DM / 128) * (2 * DFF / 64), I2 = (DFF / 128) * (DM / 64), IIN = (DM / 128) * (NIN / 64), IBR = (BRT / 128) * (DM / 64);
    ConvDesc d; d.gk = nullptr; d.W8 = nullptr; d.WT = nullptr; d.wscale = 1.0f;
    int r = it;
    if (r < 2 * I13) {
        const bool second = r >= I13; if (second) r -= I13;
        d.W = (second ? a.ffn2_w13 : a.ffn1_w13) + (size_t)l * DM * 2 * DFF; d.WT = (bf16_t*)(ws + (second ? WS_W13B : WS_W13A));
        const int nblk = 2 * DFF / 64, kb = r / nblk, nb = r % nblk, n0 = 64 * nb;
        const int isup = n0 >= DFF; const int j = isup ? n0 - DFF : n0;
        d.K = DM; d.N = 2 * DFF; d.k0 = 128 * kb; d.n0 = n0; d.drow0 = 256 * (j / 128) + (isup ? 128 : 0) + (j % 128);
        d.gk = (second ? a.ffn2_norm : a.ffn1_norm) + (size_t)(l * 2) * DM; d.wscale = __uint_as_float((unsigned)__builtin_amdgcn_readfirstlane((int)(isup ? 0xbf317218u : 0xbfb8aa3bu))); return d; }
    r -= 2 * I13;
    if (r < 2 * I2) {
        const bool second = r >= I2; if (second) r -= I2;
        d.W = (second ? a.ffn2_w2 : a.ffn1_w2) + (size_t)l * DFF * DM; d.WT = (bf16_t*)(ws + (second ? WS_W2B : WS_W2A));
        const int nblk = DM / 64, kb = r / nblk, nb = r % nblk;
        d.K = DFF; d.N = DM; d.k0 = 128 * kb; d.n0 = 64 * nb; d.drow0 = 64 * nb; return d; }
    r -= 2 * I2;
    if (r < IIN) { const int nblk = NIN / 64, kb = r / nblk, nb = r % nblk;
        d.W = a.w_in + (size_t)l * DM * NIN; d.K = DM; d.N = NIN; d.k0 = 128 * kb; d.n0 = 64 * nb; d.gk = a.mix_norm + (size_t)(l * 2) * DM;
        if (64 * nb >= MIXIN && ((F8MASK >> ((64 * nb - MIXIN) / DM)) & 1)) { d.W8 = ws + WS_WG8; d.drow0 = 64 * nb - MIXIN; d.wscale = GATE_WSCALE; }
        else { d.WT = (bf16_t*)(ws + WS_WIN); d.drow0 = 64 * nb; }
        return d; }
    r -= IIN;
    if (r < IBR) { const int nblk = DM / 64, kb = r / nblk, nb = r % nblk;
        d.W = a.w_branch + (size_t)l * BRT * DM; d.WT = (bf16_t*)(ws + WS_WBR); d.K = BRT; d.N = DM; d.k0 = 128 * kb; d.n0 = 64 * nb; d.drow0 = 64 * nb; return d; }
    r -= IBR;
    { const int nblk = DM / 64, kb = r / nblk, nb = r % nblk;
        d.W = a.w_out + (size_t)l * DM * DM; d.WT = (bf16_t*)(ws + WS_WOUT); d.K = DM; d.N = DM; d.k0 = 128 * kb; d.n0 = 64 * nb; d.drow0 = 64 * nb; return d; }
}
__device__ __forceinline__ void conv_load(const ConvDesc& d, float (&v)[16], int wave, int lane) {
#pragma unroll
    for (int i = 0; i < 16; ++i) { const int k = d.k0 + wave * 16 + i; v[i] = d.W[(size_t)k * d.N + d.n0 + lane] * ((d.gk ? d.gk[k] : 1.0f) * d.wscale); }
}
__device__ __forceinline__ void convert_weights(const Args& a, int l, LAS unsigned char* lds, int bid, int G, int lane, int wave) {
    LAS float* tile = (LAS float*)lds;
    constexpr int I13 = (DM / 128) * (2 * DFF / 64), I2 = (DFF / 128) * (DM / 64), IIN = (DM / 128) * (NIN / 64), IBR = (BRT / 128) * (DM / 64), IOUT = (DM / 128) * (DM / 64);
    constexpr int NITEMS = 2 * I13 + 2 * I2 + IIN + IBR + IOUT;
    asm volatile("" : "+s"(bid));
    if (bid >= NITEMS) return;
    float v[16];
    { const ConvDesc d0 = conv_desc(a, l, bid); conv_load(d0, v, wave, lane); }
    for (int it = bid; it < NITEMS; it += G) {
        __syncthreads();
#pragma unroll
        for (int i = 0; i < 16; ++i) tile[(wave * 16 + i) * 65 + lane] = v[i];
        __syncthreads();
        if (it + G < NITEMS) { const ConvDesc dn = conv_desc(a, l, it + G); conv_load(dn, v, wave, lane); }
        const ConvDesc c = conv_desc(a, l, it);
#pragma unroll
        for (int j = 0; j < 8; ++j) { const int n = wave * 8 + j; const float lo = tile[(2 * lane) * 65 + n], hi = tile[(2 * lane + 1) * 65 + n];
            if (c.W8) *(unsigned short*)(c.W8 + (size_t)(c.drow0 + n) * c.K + c.k0 + 2 * lane) = (unsigned short)(__builtin_amdgcn_cvt_pk_fp8_f32(lo, hi, 0, false) & 0xffff);
            else *(unsigned*)(c.WT + (size_t)(c.drow0 + n) * c.K + c.k0 + 2 * lane) = cvt_pk_b16(lo, hi); }
    }
}

__device__ __forceinline__ void prenorm_rows(const float* x, bf16_t* xn, float* rstd_out, int gw, int NGW, int lane) {
    for (int m = gw; m < M; m += NGW) {
        const float* xr = x + (size_t)m * DM; float v[32]; float ss = 0.f;
#pragma unroll
        for (int j = 0; j < 4; ++j) { const f32x4 a0 = *(const f32x4*)(xr + 512 * j + 8 * lane), a1 = *(const f32x4*)(xr + 512 * j + 8 * lane + 4);
#pragma unroll
            for (int e = 0; e < 4; ++e) { v[8 * j + e] = a0[e]; v[8 * j + 4 + e] = a1[e]; ss += a0[e] * a0[e] + a1[e] * a1[e]; } }
        const float rstd = rsqrtf(wave_sum(ss) * (1.0f / DM) + EPS);
#pragma unroll
        for (int j = 0; j < 4; ++j) {
            u32x4 w; w.x = cvt_pk_b16(v[8 * j + 0] * rstd, v[8 * j + 1] * rstd); w.y = cvt_pk_b16(v[8 * j + 2] * rstd, v[8 * j + 3] * rstd);
            w.z = cvt_pk_b16(v[8 * j + 4] * rstd, v[8 * j + 5] * rstd); w.w = cvt_pk_b16(v[8 * j + 6] * rstd, v[8 * j + 7] * rstd);
            *(u32x4*)(xn + (size_t)m * DM + 512 * j + 8 * lane) = w; }
        if (lane == 0) rstd_out[m] = rstd;
    }
}
__device__ __forceinline__ void resnorm_rows(const bf16_t* f, bf16_t* xn, float* rstd, float* hout32, float coef, const float* g_post, int gw, int NGW, int lane, unsigned char* xn8 = nullptr) {
    float gp[32];
#pragma unroll
    for (int j = 0; j < 4; ++j) { const f32x4 a0 = *(const f32x4*)(g_post + 512 * j + 8 * lane), a1 = *(const f32x4*)(g_post + 512 * j + 8 * lane + 4);
#pragma unroll
        for (int e = 0; e < 4; ++e) { gp[8 * j + e] = a0[e] * coef; gp[8 * j + 4 + e] = a1[e] * coef; } }
    u32x4 fw[4], hw[4]; float rprev = 1.0f;
#pragma unroll
    for (int j = 0; j < 4; ++j) { fw[j] = (u32x4){0u, 0u, 0u, 0u}; hw[j] = (u32x4){0u, 0u, 0u, 0u}; }
    auto issue = [&](int m) {
#pragma unroll
        for (int j = 0; j < 4; ++j) { const size_t off = (size_t)m * DM + 512 * j + 8 * lane; fw[j] = *(const u32x4*)(f + off); hw[j] = *(const u32x4*)(xn + off); }
        rprev = rstd[m]; };
    if (gw < M) issue(gw);
    for (int m = gw; m < M; m += NGW) {
        float fv[32], hv[32]; float ss = 0.f; const float hs = 1.0f / rprev;
#pragma unroll
        for (int j = 0; j < 4; ++j) { const u32x4 w = fw[j];
            fv[8 * j + 0] = bflo(w.x); fv[8 * j + 1] = bfhi(w.x); fv[8 * j + 2] = bflo(w.y); fv[8 * j + 3] = bfhi(w.y); fv[8 * j + 4] = bflo(w.z); fv[8 * j + 5] = bfhi(w.z); fv[8 * j + 6] = bflo(w.w); fv[8 * j + 7] = bfhi(w.w);
            const u32x4 h4 = hw[j];
            hv[8 * j + 0] = b16lo(h4.x) * hs; hv[8 * j + 1] = b16hi(h4.x) * hs; hv[8 * j + 2] = b16lo(h4.y) * hs; hv[8 * j + 3] = b16hi(h4.y) * hs; hv[8 * j + 4] = b16lo(h4.z) * hs; hv[8 * j + 5] = b16hi(h4.z) * hs; hv[8 * j + 6] = b16lo(h4.w) * hs; hv[8 * j + 7] = b16hi(h4.w) * hs;
#pragma unroll
            for (int e = 0; e < 8; ++e) ss += fv[8 * j + e] * fv[8 * j + e]; }
        if (m + NGW < M) issue(m + NGW);
        const float rs = rsqrtf(wave_sum(ss) * (1.0f / DM) + EPS);
        float ss2 = 0.f;
#pragma unroll
        for (int j = 0; j < 4; ++j) {
#pragma unroll
            for (int e = 0; e < 8; ++e) { const float o = hv[8 * j + e] + fv[8 * j + e] * rs * gp[8 * j + e]; ss2 += o * o; fv[8 * j + e] = o; }
            if (hout32) { const size_t off = (size_t)m * DM + 512 * j + 8 * lane;
                *(f32x4*)(hout32 + off) = (f32x4){fv[8 * j + 0], fv[8 * j + 1], fv[8 * j + 2], fv[8 * j + 3]}; *(f32x4*)(hout32 + off + 4) = (f32x4){fv[8 * j + 4], fv[8 * j + 5], fv[8 * j + 6], fv[8 * j + 7]}; } }
        if (!hout32) {
            const float rn = rsqrtf(wave_sum(ss2) * (1.0f / DM) + EPS);
#pragma unroll
            for (int j = 0; j < 4; ++j) {
                u32x4 w; w.x = cvt_pk_b16(fv[8 * j + 0] * rn, fv[8 * j + 1] * rn); w.y = cvt_pk_b16(fv[8 * j + 2] * rn, fv[8 * j + 3] * rn);
                w.z = cvt_pk_b16(fv[8 * j + 4] * rn, fv[8 * j + 5] * rn); w.w = cvt_pk_b16(fv[8 * j + 6] * rn, fv[8 * j + 7] * rn);
                *(u32x4*)(xn + (size_t)m * DM + 512 * j + 8 * lane) = w;
                if (xn8) { u32x2 b; b.x = pk_fp8x4(fv[8 * j + 0] * rn, fv[8 * j + 1] * rn, fv[8 * j + 2] * rn, fv[8 * j + 3] * rn); b.y = pk_fp8x4(fv[8 * j + 4] * rn, fv[8 * j + 5] * rn, fv[8 * j + 6] * rn, fv[8 * j + 7] * rn);
                    *(u32x2*)(xn8 + (size_t)m * DM + 512 * j + 8 * lane) = b; } }
            if (lane == 0) rstd[m] = rn;
        }
    }
}

__device__ __forceinline__ int rel_bucket(int dist) {
    if (dist < 16) return dist;
    const float d = (float)dist;
    int large = 16 + (int)(logf(d / 16.0f) / 4.852030263919617f * 16.0f);
    return large < 31 ? large : 31;
}

struct WinArgs {
    const bf16_t* q; const bf16_t* k; const bf16_t* v;
    long rstride;
    int first;
    int maxdist;
    const float* biascol; int dil;
    float sink; int has_sink;
    bf16_t* out; long ostride;
    float* lse; long lstride;
};
constexpr int AW_KS = 0, AW_VT = 36864, AW_PS = 36864 + 36864, AW_BT = AW_PS + 8 * 5376;
struct WinRegs { u32x4 k[4], v[4]; bf16x8 q0, q1; float bias; };
__device__ __forceinline__ void win_fetch(const WinArgs& A, int tid, int wave, int lane, WinRegs& R) {
#pragma unroll
    for (int i = 0; i < 4; ++i) {
        const int cidx = tid + 512 * i, j = cidx >> 3, part = cidx & 7;
        R.k[i] = (u32x4){0u, 0u, 0u, 0u}; R.v[i] = (u32x4){0u, 0u, 0u, 0u};
        if (!(A.first && j < 128)) { R.k[i] = *(const u32x4*)(A.k + (long)j * A.rstride + part * 8); R.v[i] = *(const u32x4*)(A.v + (long)j * A.rstride + part * 8); }
    }
    const bf16_t* qrow = A.q + (long)(16 * wave + (lane & 15)) * A.rstride;
    R.q0 = *(const bf16x8*)(qrow + 8 * (lane >> 4)); R.q1 = *(const bf16x8*)(qrow + 32 + 8 * (lane >> 4));
    R.bias = -3.0e38f;
    if (tid < 384) { const int dd = tid - 128; if (dd >= 0 && dd <= A.maxdist) R.bias = A.biascol[rel_bucket(dd * A.dil) * 20]; }
}
__device__ __forceinline__ void attn_win_item(LAS unsigned char* lds, const WinArgs& A, WinRegs& R, bool hasnext, const WinArgs& An, int tid, int wave, int lane) {
    LAS bf16_t* KS = (LAS bf16_t*)(lds + AW_KS);
    LAS bf16_t* VT = (LAS bf16_t*)(lds + AW_VT);
    LAS bf16_t* PS = (LAS bf16_t*)(lds + AW_PS) + wave * (16 * 168);
    LAS float* BT = (LAS float*)(lds + AW_BT);
    __syncthreads();
#pragma unroll
    for (int i = 0; i < 4; ++i) {
        const int cidx = tid + 512 * i, j = cidx >> 3, part = cidx & 7;
        *(LAS u32x4*)(KS + j * 72 + part * 8) = R.k[i];
        *(LAS u32x4*)(VT + j * 72 + part * 8) = R.v[i];
    }
    if (tid < 384) BT[tid] = R.bias;
    const bf16x8 qa0 = R.q0, qa1 = R.q1;
    __syncthreads();
    if (hasnext) win_fetch(An, tid, wave, lane, R);
    const int c = lane & 15, g = lane >> 4, st = wave < 6 ? wave : 6;
    *(LAS u32x2*)(PS + (lane >> 2) * 168 + (wave == 7 ? 0 : 144) + 4 * (lane & 3)) = (u32x2){0u, 0u};
    const int pc0 = 16 * (wave - st);
    f32x4 s[9];
#pragma unroll
    for (int jt = 0; jt < 9; ++jt) {
        const LAS bf16_t* kr = KS + (16 * (wave + jt) + c) * 72 + 8 * g;
        const bf16x8 kb0 = *(const LAS bf16x8*)kr, kb1 = *(const LAS bf16x8*)(kr + 32);
        f32x4 z = (f32x4){0.f, 0.f, 0.f, 0.f};
        z = MFMA16(qa0, kb0, z);
        z = MFMA16(qa1, kb1, z);
        s[jt] = z;
    }
    float mx[4] = {-3.0e38f, -3.0e38f, -3.0e38f, -3.0e38f};
    { const LAS float* bp = BT + (4 * g - c + 256 - 128);
#pragma unroll
      for (int jt = 0; jt < 9; ++jt) {
#pragma unroll
          for (int i = 0; i < 4; ++i) { const float lg = s[jt][i] * 0.125f + bp[128 + i - 16 * jt]; s[jt][i] = lg; mx[i] = fmaxf(mx[i], lg); } }
      if (A.first) {
#pragma unroll
          for (int jt = 0; jt < 9; ++jt) { if (16 * (wave + jt) + c < 128) {
#pragma unroll
              for (int i = 0; i < 4; ++i) s[jt][i] = -3.0e38f; } }
#pragma unroll
          for (int i = 0; i < 4; ++i) { mx[i] = -3.0e38f;
#pragma unroll
              for (int jt = 0; jt < 9; ++jt) mx[i] = fmaxf(mx[i], s[jt][i]); } } }
#pragma unroll
    for (int i = 0; i < 4; ++i) {
        mx[i] = row16_max(mx[i]);
        if (A.has_sink) mx[i] = fmaxf(mx[i], A.sink);
    }
    float sm[4] = {0.f, 0.f, 0.f, 0.f};
#pragma unroll
    for (int jt = 0; jt < 9; ++jt) {
#pragma unroll
        for (int i = 0; i < 4; ++i) {
            const float p = __expf(s[jt][i] - mx[i]);
            sm[i] += p;
            PS[(4 * g + i) * 168 + pc0 + 16 * jt + c] = f2bf(p);
        }
    }
#pragma unroll
    for (int i = 0; i < 4; ++i) {
        sm[i] = row16_sum(sm[i]);
        if (A.has_sink) sm[i] += __expf(A.sink - mx[i]);
    }
    LDS_WAIT();
    f32x4 o[4];
#pragma unroll
    for (int dt = 0; dt < 4; ++dt) o[dt] = (f32x4){0.f, 0.f, 0.f, 0.f};
    const unsigned vaddr = lds_addr(VT + (16 * st + 8 * g + (c >> 2)) * 72 + 4 * (c & 3));
#pragma unroll
    for (int ks = 0; ks < 5; ++ks) {
        const bf16x8 pa = *(const LAS bf16x8*)(PS + c * 168 + 32 * ks + 8 * g);
        bf16x8 vb[4]; tr_frag4<576>(vaddr + ks * (32 * 144), vb);
#pragma unroll
        for (int dt = 0; dt < 4; ++dt) o[dt] = MFMA16(pa, vb[dt], o[dt]);
    }
#pragma unroll
    for (int i = 0; i < 4; ++i) {
        const float inv = 1.0f / sm[i];
        bf16_t* orow = A.out + (long)(16 * wave + 4 * g + i) * A.ostride;
#pragma unroll
        for (int dt = 0; dt < 4; ++dt) orow[16 * dt + c] = A.has_sink ? f2b16(o[dt][i] * inv) : f2bf(o[dt][i] * inv);
        if (A.lse && c == 0) A.lse[(long)(16 * wave + 4 * g + i) * A.lstride] = mx[i] + __logf(sm[i]);
    }
}

constexpr float SB_THR = -30.0f;
constexpr int SB_KS = 0, SB_VT = 18432, SB_PS = 18432 + 18432;
__device__ __forceinline__ void stickbreak_item(LAS unsigned char* lds, volatile LAS unsigned* flag, const bf16_t* proj, bf16_t* yall, int b, int h, int nb, int tid, int wave, int lane) {
    LAS bf16_t* KS = (LAS bf16_t*)(lds + SB_KS);
    LAS bf16_t* VT = (LAS bf16_t*)(lds + SB_VT);
    LAS bf16_t* PS = (LAS bf16_t*)(lds + SB_PS) + wave * (16 * 136);
    const int c = lane & 15, g = lane >> 4;
    const long tok0 = (long)b * SEQ + 128 * nb;
    const bf16_t* qrow = proj + (tok0 + 16 * wave + c) * MIXIN + BQ + h * 64;
    const bf16x8 qa0 = *(const bf16x8*)(qrow + 8 * g), qa1 = *(const bf16x8*)(qrow + 32 + 8 * g);
    float R[4] = {0.f, 0.f, 0.f, 0.f};
    f32x4 o[4];
#pragma unroll
    for (int dt = 0; dt < 4; ++dt) o[dt] = (f32x4){0.f, 0.f, 0.f, 0.f};
    bool wdone = false;
    if (tid == 0) flag[0] = 0u;
    for (int kb = nb; kb >= 0; --kb) {
        __syncthreads();
        const bf16_t* kbase = proj + ((long)b * SEQ + 128 * kb) * MIXIN + h * 64;
#pragma unroll
        for (int i = 0; i < 2; ++i) {
            const int cidx = tid + 512 * i, j = cidx >> 3, part = cidx & 7;
            const u32x4 kw = *(const u32x4*)(kbase + (long)j * MIXIN + BKo + part * 8), vw = *(const u32x4*)(kbase + (long)j * MIXIN + BVo + part * 8);
            *(LAS u32x4*)(KS + j * 72 + part * 8) = kw;
            *(LAS u32x4*)(VT + j * 72 + part * 8) = vw;
        }
        __syncthreads();
        if (!wdone) {
            const bool diag = (kb == nb);
            const int jt_hi = diag ? wave : 7;
            if (diag) { for (int jt = wave + 1; jt < 8; ++jt) {
#pragma unroll
                    for (int i = 0; i < 4; ++i) PS[(4 * g + i) * 136 + 16 * jt + c] = 0; } }
            for (int jt = jt_hi; jt >= 0; --jt) {
                const LAS bf16_t* kr = KS + (16 * jt + c) * 72 + 8 * g;
                const bf16x8 kb0 = *(const LAS bf16x8*)kr, kb1 = *(const LAS bf16x8*)(kr + 32);
                f32x4 z = (f32x4){0.f, 0.f, 0.f, 0.f};
                z = MFMA16(qa0, kb0, z);
                z = MFMA16(qa1, kb1, z);
#pragma unroll
                for (int i = 0; i < 4; ++i) {
                    const float zz = z[i] * 0.125f;
                    const bool past = !diag || jt < wave || c < 4 * g + i;
                    const float sp = fmaxf(zz, 0.f) + __logf(1.0f + __expf(-fabsf(zz)));
                    const float lk = past ? -sp : 0.f;
                    float inc = lk;
                    inc += dpp_f<0x101>(inc); inc += dpp_f<0x102>(inc); inc += dpp_f<0x104>(inc); inc += dpp_f<0x108>(inc);
                    const float between = R[i] + inc - lk;
                    const float a = past ? __expf(zz - sp + between) : 0.f;
                    R[i] += __shfl(inc, 0, 16);
                    PS[(4 * g + i) * 136 + 16 * jt + c] = f2bf(a);
                }
                if (jt > 0 && __all(fmaxf(fmaxf(R[0], R[1]), fmaxf(R[2], R[3])) < SB_THR)) {
                    for (int j2 = jt - 1; j2 >= 0; --j2) {
#pragma unroll
                        for (int i = 0; i < 4; ++i) PS[(4 * g + i) * 136 + 16 * j2 + c] = 0; }
                    break; }
            }
            LDS_WAIT();
#pragma unroll
            for (int ks = 0; ks < 4; ++ks) {
                const bf16x8 pa = *(const LAS bf16x8*)(PS + c * 136 + 32 * ks + 8 * g);
                bf16x8 vb[4]; tr_frag4<576>(lds_addr(VT + (8 * g + (c >> 2)) * 72 + 4 * (c & 3)) + ks * (32 * 144), vb);
#pragma unroll
                for (int dt = 0; dt < 4; ++dt) o[dt] = MFMA16(pa, vb[dt], o[dt]);
            }
            const float rmax = fmaxf(fmaxf(R[0], R[1]), fmaxf(R[2], R[3]));
            wdone = __all(rmax < SB_THR);
        }
        if (!wdone && lane == 0) flag[0] = (unsigned)(kb + 1);
        __syncthreads();
        if (flag[0] != (unsigned)(kb + 1)) break;
    }
#pragma unroll
    for (int i = 0; i < 4; ++i) {
        bf16_t* orow = yall + (tok0 + 16 * wave + 4 * g + i) * BRT + 512 + h * 64;
#pragma unroll
        for (int dt = 0; dt < 4; ++dt) orow[16 * dt + c] = f2b16(o[dt][i]);
    }
}

constexpr int H1_GT = 0, H1_BR = 2048, H1_BL = 2560, H1_QS = 3072, H1_KS = H1_QS + 33792, H1_KDT = H1_KS + 33792, H1_VT = H1_KDT + 18432, H1_PS = H1_VT + 18432;
__device__ __forceinline__ void hgrn_a1_load(const Args& a, int item, int tid, unsigned (&fq)[16], unsigned (&vp)[8]) {
    const bf16_t* proj = (const bf16_t*)(a.ws + WS_PROJ);
    const int cch = item & 63, h = (item >> 6) & 3, b = item >> 8, k = tid & 127, rg = tid >> 7;
    const bf16_t* p = proj + ((long)b * SEQ + 64 * cch + 16 * rg) * MIXIN + h * 128 + k;
#pragma unroll
    for (int r = 0; r < 16; ++r) { const unsigned f = p[(long)r * MIXIN + AF], q = p[(long)r * MIXIN + AQ], v = p[(long)r * MIXIN + AI]; fq[r] = f | (q << 16); if (r & 1) vp[r >> 1] |= v << 16; else vp[r >> 1] = v; }
}
__device__ __forceinline__ void hgrn_a1_item(LAS unsigned char* lds, const Args& a, int l, int item, int next_item, unsigned (&fq)[16], unsigned (&vp)[8], int tid, int wave, int lane) {
    const int cch = item & 63, h = (item >> 6) & 3, b = item >> 8;
    const long tok0 = (long)b * SEQ + 64 * cch;
    LAS float* GT = (LAS float*)(lds + H1_GT);
    LAS float* BR = (LAS float*)(lds + H1_BR);
    LAS float* BL = (LAS float*)(lds + H1_BL);
    LAS float* QS = (LAS float*)(lds + H1_QS);
    LAS float* KS = (LAS float*)(lds + H1_KS);
    LAS bf16_t* KDT = (LAS bf16_t*)(lds + H1_KDT);
    LAS bf16_t* VT = (LAS bf16_t*)(lds + H1_VT);
    LAS bf16_t* PS = (LAS bf16_t*)(lds + H1_PS);
    const int k = tid & 127, rg = tid >> 7;
    float lb;
    { const float* lg = a.lb_logits + h * 128 + k; const float l0 = lg[0], l1 = lg[512], l2 = lg[1024], l3 = lg[1536];
      const float mxl = fmaxf(fmaxf(l0, l1), fmaxf(l2, l3)); const float e0 = __expf(l0 - mxl), e1 = __expf(l1 - mxl), e2 = __expf(l2 - mxl), e3 = __expf(l3 - mxl);
      const float inv = 1.0f / (e0 + e1 + e2 + e3);
      lb = (l >= 1 ? e1 : 0.f) + (l >= 2 ? e2 : 0.f) + (l >= 3 ? e3 : 0.f); lb *= inv; }
    __syncthreads();
    float kk[16], bb[16];
    { float run = 0.f;
#pragma unroll
      for (int r = 0; r < 16; ++r) { const float fl = bf2f((bf16_t)(fq[r] & 0xffffu));
          const float f = lb + (1.0f - lb) * fast_sigmoid(fl); kk[r] = 1.0f - f; run += __logf(f); bb[r] = run; }
      GT[rg * 128 + k] = run; }
    __syncthreads();
    { float pre = 0.f;
#pragma unroll
      for (int r2 = 0; r2 < 3; ++r2) pre += (r2 < rg) ? GT[r2 * 128 + k] : 0.f;
#pragma unroll
      for (int r = 0; r < 16; ++r) bb[r] += pre;
      if (rg == 1) BR[k] = bb[15];
      if (rg == 3) BL[k] = bb[15]; }
    __syncthreads();
    { const float bref = BR[k], blast = BL[k];
      bf16_t* qi_out = (bf16_t*)(a.ws + WS_QI) + ((size_t)item * 64 + 16 * rg) * 128 + k;
      unsigned kd[8];
#pragma unroll
      for (int r = 0; r < 16; ++r) {
          const float q = bf2f((bf16_t)(fq[r] >> 16));
          const float qs = q * __expf(bb[r] - bref), ks = kk[r] * __expf(bref - bb[r]), kdv = kk[r] * __expf(blast - bb[r]), qi = q * __expf(bb[r]);
          QS[(16 * rg + r) * 132 + k] = qs; KS[(16 * rg + r) * 132 + k] = ks;
          qi_out[(size_t)r * 128] = f2bf(qi);
          const unsigned kdb = f2bf(kdv);
          if (r & 1) kd[r >> 1] |= kdb << 16; else kd[r >> 1] = kdb;
      }
      *(LAS u32x4*)(KDT + k * 72 + 16 * rg) = (u32x4){kd[0], kd[1], kd[2], kd[3]}; *(LAS u32x4*)(KDT + k * 72 + 16 * rg + 8) = (u32x4){kd[4], kd[5], kd[6], kd[7]};
      *(LAS u32x4*)(VT + k * 72 + 16 * rg) = (u32x4){vp[0], vp[1], vp[2], vp[3]}; *(LAS u32x4*)(VT + k * 72 + 16 * rg + 8) = (u32x4){vp[4], vp[5], vp[6], vp[7]};
      if (rg == 3) ((float*)(a.ws + WS_DC))[(size_t)item * 128 + k] = __expf(blast); }
    if (next_item >= 0) hgrn_a1_load(a, next_item, tid, fq, vp);
    __syncthreads();
    const int c = lane & 15, g = lane >> 4;
    { const int mt = wave >> 1;
#pragma unroll
      for (int e = 0; e < 2; ++e) { const int nt = 2 * (wave & 1) + e;
          f32x4 z = (f32x4){0.f, 0.f, 0.f, 0.f};
          if (nt <= mt) {
#pragma unroll
              for (int Mi = 0; Mi < 8; ++Mi) { const f32x4 a4 = *(const LAS f32x4*)(QS + (16 * mt + c) * 132 + 16 * Mi + 4 * g), b4 = *(const LAS f32x4*)(KS + (16 * nt + c) * 132 + 16 * Mi + 4 * g);
#pragma unroll
                  for (int j = 0; j < 4; ++j) z = __builtin_amdgcn_mfma_f32_16x16x4f32(a4[j], b4[j], z, 0, 0, 0); } }
#pragma unroll
          for (int i = 0; i < 4; ++i) { const int t = 16 * mt + 4 * g + i, s = 16 * nt + c; PS[t * 72 + s] = (s <= t) ? f2bf(z[i]) : (bf16_t)0; } } }
    __syncthreads();
    { const int mt = wave >> 1;
      bf16_t* oi = (bf16_t*)(a.ws + WS_OINTRA) + (size_t)item * 64 * 128;
      bf16x8 pa[2];
#pragma unroll
      for (int ks = 0; ks < 2; ++ks) pa[ks] = *(const LAS bf16x8*)(PS + (16 * mt + c) * 72 + 32 * ks + 8 * g);
#pragma unroll
      for (int e = 0; e < 4; ++e) { const int vt = 4 * (wave & 1) + e; f32x4 z = (f32x4){0.f, 0.f, 0.f, 0.f};
#pragma unroll
          for (int ks = 0; ks < 2; ++ks) { const bf16x8 vb = *(const LAS bf16x8*)(VT + (16 * vt + c) * 72 + 32 * ks + 8 * g); z = MFMA16(vb, pa[ks], z); }
          u32x2 w; w.x = cvt_pk_bf16(z[0], z[1]); w.y = cvt_pk_bf16(z[2], z[3]); *(u32x2*)(oi + (size_t)(16 * mt + c) * 128 + 16 * vt + 4 * g) = w; }
      bf16_t* U = (bf16_t*)(a.ws + WS_U) + (size_t)item * 128 * 128;
      bf16x8 ka[2];
#pragma unroll
      for (int ks = 0; ks < 2; ++ks) ka[ks] = *(const LAS bf16x8*)(KDT + (16 * wave + c) * 72 + 32 * ks + 8 * g);
#pragma unroll
      for (int vt = 0; vt < 8; ++vt) { f32x4 z = (f32x4){0.f, 0.f, 0.f, 0.f};
#pragma unroll
          for (int ks = 0; ks < 2; ++ks) { const bf16x8 vb = *(const LAS bf16x8*)(VT + (16 * vt + c) * 72 + 32 * ks + 8 * g); z = MFMA16(vb, ka[ks], z); }
          u32x2 w; w.x = cvt_pk_bf16(z[0], z[1]); w.y = cvt_pk_bf16(z[2], z[3]); *(u32x2*)(U + (size_t)(16 * wave + c) * 128 + 16 * vt + 4 * g) = w; } }
}
__device__ __forceinline__ void hgrn_a2(const Args& a, int gtid, int gthreads) {
    const bf16_t* U = (const bf16_t*)(a.ws + WS_U); const float* DC = (const float*)(a.ws + WS_DC); bf16_t* SP = (bf16_t*)(a.ws + WS_SPREV);
    for (int e = gtid; e < 32 * 128 * 32; e += gthreads) {
        const int v4 = e & 31, k = (e >> 5) & 127, bh = e >> 12;
        f32x4 S = (f32x4){0.f, 0.f, 0.f, 0.f};
        u32x2 ub[8]; float db[8];
#pragma unroll
        for (int j = 0; j < 8; ++j) { const size_t it = (size_t)bh * 64 + j; ub[j] = *(const u32x2*)(U + (it * 128 + k) * 128 + 4 * v4); db[j] = DC[it * 128 + k]; }
        for (int c0 = 0; c0 < 64; c0 += 8) {
#pragma unroll
            for (int j = 0; j < 8; ++j) {
                const size_t it = (size_t)bh * 64 + c0 + j;
                const u32x2 uw = ub[j]; const float d = db[j];
                if (c0 + 8 < 64) { const size_t itn = it + 8; ub[j] = *(const u32x2*)(U + (itn * 128 + k) * 128 + 4 * v4); db[j] = DC[itn * 128 + k]; }
                const f32x4 u = (f32x4){bflo(uw.x), bfhi(uw.x), bflo(uw.y), bfhi(uw.y)};
                u32x2 w; w.x = cvt_pk_bf16(S[0], S[1]); w.y = cvt_pk_bf16(S[2], S[3]);
                *(u32x2*)(SP + (it * 128 + k) * 128 + 4 * v4) = w;
                S = S * d + u;
            }
        }
    }
}
constexpr int H3_ST = 0, H3_SS = 36864;
__device__ __forceinline__ void hgrn_a3_item(LAS unsigned char* lds, const Args& a, int l, int item, int tid, int wave, int lane) {
    const bf16_t* proj = (const bf16_t*)(a.ws + WS_PROJ); bf16_t* yall = (bf16_t*)(a.ws + WS_YALL);
    const int cch = item & 63, h = (item >> 6) & 3, b = item >> 8;
    const long tok0 = (long)b * SEQ + 64 * cch;
    LAS bf16_t* ST = (LAS bf16_t*)(lds + H3_ST); LAS float* SS = (LAS float*)(lds + H3_SS);
    const bf16_t* SP = (const bf16_t*)(a.ws + WS_SPREV) + (size_t)item * 128 * 128;
    __syncthreads();
#pragma unroll
    for (int i = 0; i < 4; ++i) { const int cidx = tid + 512 * i, kr = cidx >> 4, part = cidx & 15;
        const u32x4 w = *(const u32x4*)(SP + (size_t)kr * 128 + 8 * part);
        *(LAS u32x4*)(ST + kr * 144 + 8 * part) = w; }
    __syncthreads();
    const int c = lane & 15, g = lane >> 4, mt = wave >> 1;
    const bf16_t* qi = (const bf16_t*)(a.ws + WS_QI) + ((size_t)item * 64 + 16 * mt + c) * 128;
    const bf16_t* oi = (const bf16_t*)(a.ws + WS_OINTRA) + (size_t)item * 64 * 128;
    bf16x8 qa[4];
#pragma unroll
    for (int ks = 0; ks < 4; ++ks) qa[ks] = *(const bf16x8*)(qi + 32 * ks + 8 * g);
    f32x4 o[4];
#pragma unroll
    for (int e = 0; e < 4; ++e) o[e] = (f32x4){0.f, 0.f, 0.f, 0.f};
    { const unsigned saddr = lds_addr(ST + (8 * g + (c >> 2)) * 144 + 64 * (wave & 1) + 4 * (c & 3));
#pragma unroll
      for (int ks = 0; ks < 4; ++ks) { bf16x8 sb[4]; tr_frag4<1152>(saddr + ks * (32 * 288), sb);
#pragma unroll
          for (int e = 0; e < 4; ++e) o[e] = MFMA16(sb[e], qa[ks], o[e]); } }
    const int t = 16 * mt + c; float ss = 0.f;
#pragma unroll
    for (int e = 0; e < 4; ++e) { const int v0 = 16 * (4 * (wave & 1) + e) + 4 * g; const u32x2 w = *(const u32x2*)(oi + (size_t)t * 128 + v0);
        f32x4 z = o[e]; z[0] += bflo(w.x); z[1] += bfhi(w.x); z[2] += bflo(w.y); z[3] += bfhi(w.y);
        ss += (z[0] * z[0] + z[1] * z[1]) + (z[2] * z[2] + z[3] * z[3]); o[e] = z; }
    ss += __shfl_xor(ss, 16); ss += __shfl_xor(ss, 32);
    if (g == 0) SS[t * 2 + (wave & 1)] = ss;
    __syncthreads();
    { const float rstd = rsqrtf((SS[t * 2] + SS[t * 2 + 1]) * (1.0f / 128.0f) + EPS);
      const long tok = tok0 + t;
#pragma unroll
      for (int e = 0; e < 4; ++e) { const int v0 = 16 * (4 * (wave & 1) + e) + 4 * g;
          const u32x2 gw = *(const u32x2*)(proj + tok * MIXIN + AG + h * 128 + v0); const f32x4 ng = *(const f32x4*)(a.hgrn_norm + l * 128 + v0);
          const float gt[4] = {bflo(gw.x), bfhi(gw.x), bflo(gw.y), bfhi(gw.y)}; float y[4];
#pragma unroll
          for (int i = 0; i < 4; ++i) y[i] = o[e][i] * rstd * ng[i] * (gt[i] * fast_sigmoid(gt[i]));
          u32x2 w; w.x = cvt_pk_b16(y[0], y[1]); w.y = cvt_pk_b16(y[2], y[3]); *(u32x2*)(yall + tok * BRT + h * 128 + v0) = w; } }
}
__device__ __forceinline__ void c_combine(const Args& a, int gtid, int gthreads) {
    const bf16_t* CP = (const bf16_t*)(a.ws + WS_CPART); const float* LS = (const float*)(a.ws + WS_CLSE); bf16_t* yall = (bf16_t*)(a.ws + WS_YALL);
    for (int e = gtid; e < M * 32; e += gthreads) {
        const int part = e & 31, tok = e >> 5, h4 = part >> 3;
        const float l0 = LS[(size_t)tok * 4 + h4], l1 = LS[((size_t)M + tok) * 4 + h4], l2 = LS[((size_t)2 * M + tok) * 4 + h4];
        const float mx = fmaxf(l0, fmaxf(l1, l2)); float w0 = __expf(l0 - mx), w1 = __expf(l1 - mx), w2 = __expf(l2 - mx); const float inv = 1.0f / (w0 + w1 + w2); w0 *= inv; w1 *= inv; w2 *= inv;
        const u32x4 p0 = *(const u32x4*)(CP + (size_t)tok * 256 + 8 * part), p1 = *(const u32x4*)(CP + ((size_t)M + tok) * 256 + 8 * part), p2 = *(const u32x4*)(CP + ((size_t)2 * M + tok) * 256 + 8 * part);
        u32x4 o;
        o.x = cvt_pk_b16(w0 * bflo(p0.x) + w1 * bflo(p1.x) + w2 * bflo(p2.x), w0 * bfhi(p0.x) + w1 * bfhi(p1.x) + w2 * bfhi(p2.x));
        o.y = cvt_pk_b16(w0 * bflo(p0.y) + w1 * bflo(p1.y) + w2 * bflo(p2.y), w0 * bfhi(p0.y) + w1 * bfhi(p1.y) + w2 * bfhi(p2.y));
        o.z = cvt_pk_b16(w0 * bflo(p0.z) + w1 * bflo(p1.z) + w2 * bflo(p2.z), w0 * bfhi(p0.z) + w1 * bfhi(p1.z) + w2 * bfhi(p2.z));
        o.w = cvt_pk_b16(w0 * bflo(p0.w) + w1 * bflo(p1.w) + w2 * bflo(p2.w), w0 * bfhi(p0.w) + w1 * bfhi(p1.w) + w2 * bfhi(p2.w));
        *(u32x4*)(yall + (size_t)tok * BRT + 1024 + 8 * part) = o;
    }
}

__device__ __forceinline__ WinArgs win_args_c(const Args& a, const bf16_t* proj, int it) {
    const int sub = it & 31, h4 = (it >> 5) & 3, bg = it >> 7, g = bg % 3, b = bg / 3;
    const int r = g == 0 ? 1 : (g == 1 ? 4 : 16); const int nper = 32 / r, res = sub / nper, n = sub % nper;
    const long tq = (long)b * SEQ + (long)(128 * n) * r + res, tk = tq - (long)128 * r;
    WinArgs W; W.q = proj + tq * MIXIN + CQ + g * 256 + h4 * 64; W.k = proj + tk * MIXIN + CKo + g * 256 + h4 * 64; W.v = proj + tk * MIXIN + CVo + g * 256 + h4 * 64;
    W.rstride = (long)r * MIXIN; W.first = (n == 0); W.maxdist = 128; W.biascol = a.rel_bias + g * 4 + h4; W.dil = r; W.sink = 0.f; W.has_sink = 0;
    W.out = (bf16_t*)(a.ws + WS_CPART) + ((size_t)g * M + tq) * 256 + h4 * 64; W.ostride = (long)r * 256;
    W.lse = (float*)(a.ws + WS_CLSE) + ((size_t)g * M + tq) * 4 + h4; W.lstride = (long)r * 4;
    return W;
}
__device__ __forceinline__ WinArgs win_args_d(const Args& a, const bf16_t* proj, bf16_t* yall, int l, int it) {
    const int nb = it & 31, hq = (it >> 5) & 7, b = it >> 8, kvh = hq >> 2;
    const long tq = (long)b * SEQ + 128 * nb, tk = tq - 128;
    WinArgs W; W.q = proj + tq * MIXIN + DQo + hq * 64; W.k = proj + tk * MIXIN + DKo + kvh * 64; W.v = proj + tk * MIXIN + DVo + kvh * 64;
    W.rstride = MIXIN; W.first = (nb == 0); W.maxdist = 127; W.biascol = a.rel_bias + 12 + hq; W.dil = 1; W.sink = a.sinks[l * 8 + hq]; W.has_sink = 1;
    W.out = yall + tq * BRT + 1280 + hq * 64; W.ostride = BRT; W.lse = nullptr; W.lstride = 0;
    return W;
}

constexpr int LDS_BYTES = 147456;
constexpr int LDS_MISC = 131072;
constexpr int NPH = 14;

__global__ void __launch_bounds__(512, 2) fwd_kernel(Args a) {
    extern __shared__ __attribute__((aligned(16))) unsigned char lds_raw[];
    LAS unsigned char* lds = (LAS unsigned char*)lds_raw;
    const int G = gridDim.x, bid = blockIdx.x;
    const int NGW = G * 8, gthreads = G * 512;
#define LAUNDER() int tid_ = threadIdx.x; asm volatile("" : "+v"(tid_)); const int tid = tid_, lane = tid & 63, wave = __builtin_amdgcn_readfirstlane(tid >> 6), gw = bid * 8 + wave, gtid = bid * 512 + tid; (void)lane; (void)gw; (void)gtid
    unsigned char* ws = a.ws;
    volatile LAS unsigned* MISC = (volatile LAS unsigned*)(lds + LDS_MISC);
    if (threadIdx.x < 64) MISC[threadIdx.x] = 0u;
    __syncthreads();
#if MK_ONE_LAUNCH
    XcdBarrier bar = xcd_barrier_post((unsigned*)(ws + WS_CTL) + CW_BAR, MISC + 8);
#define GRID_BAR() xcd_barrier(bar)
#else
#define GRID_BAR() do { } while (0)
#endif
    bf16_t* XN = (bf16_t*)(ws + WS_H16);
    float* RSTD = (float*)(ws + WS_CTL + 512 * 1024);
    for (int l = a.l_lo; l < a.l_hi; ++l) {
        const int lo = a.ph_lo, hi = a.ph_hi;
#define IN(k) (((PHMASK >> (k)) & 1) && lo <= (k) && (k) < hi)
        if (IN(0) && l == 0) {
            LAUNDER();
            convert_weights(a, 0, lds, bid, G, lane, wave);
            prenorm_rows(a.x, XN, RSTD, gw, NGW, lane);
            GRID_BAR();
        }
        if (IN(1)) for (int rep_ = 0; rep_ < (((RPT_MASK >> 1) & 1) ? 2 : 1); ++rep_) {
            LAUNDER();
            pg8::SchedPlain S; S.o.init(M / 256, 2 * DFF / 256, G, bid, COLCH); S.A = (const char*)XN; S.B = (const char*)(ws + WS_W13A); S.tstepA = (size_t)256 * DM * 2; S.tstepB = (size_t)256 * DM * 2; S.nt = DM / 64;
            pg8::EpiSwiglu E{(bf16_t*)(ws + WS_ACT), DFF};
            pg8::gemm_phase<false, GSP2, GALIGN>(lds, DM, DM, S, E);
            GRID_BAR();
        }
        if (IN(2)) for (int rep_ = 0; rep_ < (((RPT_MASK >> 2) & 1) ? 2 : 1); ++rep_) {
            LAUNDER();
            pg8::SchedPlain S; S.o.init(M / 256, DM / 256, G, bid, 1); S.A = (const char*)(ws + WS_ACT); S.B = (const char*)(ws + WS_W2A); S.tstepA = (size_t)256 * DFF * 2; S.tstepB = (size_t)256 * DFF * 2; S.nt = DFF / 64;
            pg8::EpiBf16 E{(bf16_t*)(ws + WS_F_FFN), DM};
            pg8::gemm_phase<false, GSP2, GALIGN>(lds, DFF, DFF, S, E);
            GRID_BAR();
        }
        if (IN(3)) {
            LAUNDER();
            resnorm_rows((const bf16_t*)(ws + WS_F_FFN), XN, RSTD, nullptr, 0.5f, a.ffn1_norm + (size_t)(l * 2 + 1) * DM, gw, NGW, lane, ws + WS_XN8);
            GRID_BAR();
        }
        if (IN(4)) for (int rep_ = 0; rep_ < (((RPT_MASK >> 4) & 1) ? 2 : 1); ++rep_) {
            LAUNDER();
#ifndef NO_PROJ
            {
                pg8::SchedPlain S; S.o.init(M / 256, MIXIN / 256, G, bid, COLCH); S.A = (const char*)XN; S.B = (const char*)(ws + WS_WIN); S.tstepA = (size_t)256 * DM * 2; S.tstepB = (size_t)256 * DM * 2; S.nt = DM / 64;
                pg8::EpiBf16 E{(bf16_t*)(ws + WS_PROJ), MIXIN};
                pg8::gemm_phase<false, GSP2, GALIGN>(lds, DM, DM, S, E); }
#endif
#ifndef NO_G8
            {
                constexpr int NB8 = ((F8MASK >> 0) & 1) + ((F8MASK >> 1) & 1) + ((F8MASK >> 2) & 1) + ((F8MASK >> 3) & 1);
                if constexpr (NB8 > 0) {
                pg8::SchedPlain S; S.o.init(M / 256, 8 * NB8, G, bid, COLCH); S.A = (const char*)(ws + WS_XN8); S.B = (const char*)(ws + WS_WG8); S.tstepA = (size_t)256 * DM; S.tstepB = (size_t)256 * DM; S.nt = DM / 128; S.bmap = branch_list(F8MASK);
                pg8::EpiGates E{ws + WS_GATES, 1.0f / GATE_WSCALE};
                pg8::gemm_phase<true, GSP2, GALIGN>(lds, DM / 2, DM / 2, S, E); }
                if constexpr (NB8 < 4) {
                pg8::SchedPlain S; S.o.init(M / 256, 8 * (4 - NB8), G, bid, COLCH); S.A = (const char*)XN; S.B = (const char*)(ws + WS_WIN) + (size_t)MIXIN * DM * 2; S.tstepA = (size_t)256 * DM * 2; S.tstepB = (size_t)256 * DM * 2; S.nt = DM / 64; S.bmap = branch_list(~F8MASK & 15);
                pg8::EpiGates E{ws + WS_GATES, 1.0f};
                pg8::gemm_phase<false, GSP2, GALIGN>(lds, DM, DM, S, E); } }
#endif
            GRID_BAR();
        }
        if (IN(5)) for (int rep_ = 0; rep_ < (((RPT_MASK >> 5) & 1) ? 2 : 1); ++rep_) {
            LAUNDER();
            const bf16_t* proj = (const bf16_t*)(ws + WS_PROJ); bf16_t* yall = (bf16_t*)(ws + WS_YALL);
            { unsigned fq[16], vp[8];
#pragma unroll
              for (int r = 0; r < 16; ++r) { fq[r] = 0u; vp[r >> 1] = 0u; }
              for (int it = bid; it < 2048; it += G) { hgrn_a1_load(a, it, tid, fq, vp); hgrn_a1_item(lds, a, l, it, -1, fq, vp, tid, wave, lane); } }
            __syncthreads();
            for (int it = bid; it < 2048; it += G) { const int nb = 31 - (it & 31), h = (it >> 5) & 7, b = it >> 8; stickbreak_item(lds, MISC + 16, proj, yall, b, h, nb, tid, wave, lane); }
            __syncthreads();
            { WinRegs R; WinArgs W = win_args_c(a, proj, bid);
              win_fetch(W, tid, wave, lane, R);
              for (int it = bid; it < 3072; it += G) { const bool hn = it + G < 3072; const WinArgs Wn = win_args_c(a, proj, hn ? it + G : it);
                  attn_win_item(lds, W, R, hn, Wn, tid, wave, lane); W = Wn; } }
            __syncthreads();
            { WinRegs R; WinArgs W = win_args_d(a, proj, yall, l, bid);
              win_fetch(W, tid, wave, lane, R);
              for (int it = bid; it < 2048; it += G) { const bool hn = it + G < 2048; const WinArgs Wn = win_args_d(a, proj, yall, l, hn ? it + G : it);
                  attn_win_item(lds, W, R, hn, Wn, tid, wave, lane); W = Wn; } }
            GRID_BAR();
        }
        if (IN(6)) for (int rep_ = 0; rep_ < (((RPT_MASK >> 6) & 1) ? 2 : 1); ++rep_) {
            LAUNDER();
            hgrn_a2(a, gtid, gthreads);
            c_combine(a, gtid, gthreads);
            GRID_BAR();
        }
        if (IN(7)) for (int rep_ = 0; rep_ < (((RPT_MASK >> 7) & 1) ? 2 : 1); ++rep_) {
            LAUNDER();
            for (int it = bid; it < 2048; it += G) hgrn_a3_item(lds, a, l, it, tid, wave, lane);
            GRID_BAR();
        }
        if (IN(8)) for (int rep_ = 0; rep_ < (((RPT_MASK >> 8) & 1) ? 2 : 1); ++rep_) {
            LAUNDER();
            pg8::SchedBranch S; S.o.init(M / 256, DM / 256, G, bid); S.A = (const char*)(ws + WS_YALL); S.B = (const char*)(ws + WS_WBR); S.tstepA = (size_t)256 * BRT * 2; S.tstepB = (size_t)256 * BRT * 2;
            pg8::EpiBranch E{(bf16_t*)(ws + WS_MERGED), ws + WS_GATES};
            pg8::gemm_phase<false, GSP2, GALIGN>(lds, BRT, BRT, S, E);
            GRID_BAR();
        }
        if (IN(9)) for (int rep_ = 0; rep_ < (((RPT_MASK >> 9) & 1) ? 2 : 1); ++rep_) {
            LAUNDER();
            pg8::SchedPlain S; S.o.init(M / 256, DM / 256, G, bid); S.A = (const char*)(ws + WS_MERGED); S.B = (const char*)(ws + WS_WOUT); S.tstepA = (size_t)256 * DM * 2; S.tstepB = (size_t)256 * DM * 2; S.nt = DM / 64;
            pg8::EpiBf16 E{(bf16_t*)(ws + WS_F_MIX), DM};
            pg8::gemm_phase<false, GSP2, GALIGN>(lds, DM, DM, S, E);
            GRID_BAR();
        }
        if (IN(10)) {
            LAUNDER();
            resnorm_rows((const bf16_t*)(ws + WS_F_MIX), XN, RSTD, nullptr, 1.0f, a.mix_norm + (size_t)(l * 2 + 1) * DM, gw, NGW, lane);
            GRID_BAR();
        }
        if (IN(11)) for (int rep_ = 0; rep_ < (((RPT_MASK >> 11) & 1) ? 2 : 1); ++rep_) {
            LAUNDER();
            pg8::SchedPlain S; S.o.init(M / 256, 2 * DFF / 256, G, bid, COLCH); S.A = (const char*)XN; S.B = (const char*)(ws + WS_W13B); S.tstepA = (size_t)256 * DM * 2; S.tstepB = (size_t)256 * DM * 2; S.nt = DM / 64;
            pg8::EpiSwiglu E{(bf16_t*)(ws + WS_ACT), DFF};
            pg8::gemm_phase<false, GSP2, GALIGN>(lds, DM, DM, S, E);
            GRID_BAR();
        }
        if (IN(12)) for (int rep_ = 0; rep_ < (((RPT_MASK >> 12) & 1) ? 2 : 1); ++rep_) {
            LAUNDER();
            pg8::SchedPlain S; S.o.init(M / 256, DM / 256, G, bid, 1); S.A = (const char*)(ws + WS_ACT); S.B = (const char*)(ws + WS_W2B); S.tstepA = (size_t)256 * DFF * 2; S.tstepB = (size_t)256 * DFF * 2; S.nt = DFF / 64;
            pg8::EpiBf16 E{(bf16_t*)(ws + WS_F_FFN), DM};
            pg8::gemm_phase<false, GSP2, GALIGN>(lds, DFF, DFF, S, E);
            GRID_BAR();
        }
        if (IN(13)) {
            LAUNDER();
            const bool lastl = (l + 1 == DEPTH);
            resnorm_rows((const bf16_t*)(ws + WS_F_FFN), XN, RSTD, lastl ? a.out : nullptr, 0.5f, a.ffn2_norm + (size_t)(l * 2 + 1) * DM, gw, NGW, lane);
            if (!lastl) { __syncthreads(); convert_weights(a, l + 1, lds, bid, G, lane, wave); GRID_BAR(); }
        }
#undef IN
    }
}

extern "C" void kernel_launch(void* const* d_in, const int* in_sizes, int n_in, void* d_out, int out_size, void* d_ws, size_t ws_size, hipStream_t stream) {
    static int grid = 0;
    if (grid == 0) {
        if (n_in != 15 || in_sizes[0] != M * DM || out_size != M * DM || ws_size < WS_END) { fprintf(stderr, "kernel_launch: unexpected shapes (n_in %d, in0 %d, out %d, ws %zu < %zu)\n", n_in, n_in > 0 ? in_sizes[0] : -1, out_size, ws_size, (size_t)WS_END); grid = -1; return; }
        int dev = 0, cus = 0, per_cu = 0;
        if (hipGetDevice(&dev) != hipSuccess || hipDeviceGetAttribute(&cus, hipDeviceAttributeMultiprocessorCount, dev) != hipSuccess) { grid = -1; return; }
        if (hipFuncSetAttribute((const void*)fwd_kernel, hipFuncAttributeMaxDynamicSharedMemorySize, LDS_BYTES) != hipSuccess) { fprintf(stderr, "kernel_launch: hipFuncSetAttribute failed\n"); grid = -1; return; }
        if (hipOccupancyMaxActiveBlocksPerMultiprocessor(&per_cu, (const void*)fwd_kernel, 512, LDS_BYTES) != hipSuccess || per_cu < 1) fprintf(stderr, "kernel_launch: occupancy query reports %d\n", per_cu);
        (void)hipGetLastError();
        grid = cus;
    }
    if (grid < 0) return;
    if (hipMemsetAsync((char*)d_ws + WS_CTL, 0, 1 * MiB, stream) != hipSuccess) return;
    Args a{};
    a.x = (const float*)d_in[0]; a.ffn1_norm = (const float*)d_in[1]; a.ffn1_w13 = (const float*)d_in[2]; a.ffn1_w2 = (const float*)d_in[3]; a.mix_norm = (const float*)d_in[4]; a.w_in = (const float*)d_in[5];
    a.lb_logits = (const float*)d_in[6]; a.hgrn_norm = (const float*)d_in[7]; a.sinks = (const float*)d_in[8]; a.w_branch = (const float*)d_in[9]; a.w_out = (const float*)d_in[10];
    a.ffn2_norm = (const float*)d_in[11]; a.ffn2_w13 = (const float*)d_in[12]; a.ffn2_w2 = (const float*)d_in[13]; a.rel_bias = (const float*)d_in[14];
    a.out = (float*)d_out; a.ws = (unsigned char*)d_ws;
#if MK_ONE_LAUNCH
    a.l_lo = 0; a.l_hi = DEPTH; a.ph_lo = 0; a.ph_hi = NPH;
    hipLaunchKernelGGL(fwd_kernel, dim3(grid), dim3(512), LDS_BYTES, stream, a);
#else
    for (int l = 0; l < DEPTH; ++l)
        for (int p = (l == 0 ? 0 : 1); p < NPH; ++p) { a.l_lo = l; a.l_hi = l + 1; a.ph_lo = p; a.ph_hi = p + 1; hipLaunchKernelGGL(fwd_kernel, dim3(grid), dim3(512), LDS_BYTES, stream, a); }
#endif
}
```

```cpp
#include <hip/hip_runtime.h>
#include <cstdio>

#ifndef MK_ONE_LAUNCH
#define MK_ONE_LAUNCH 1
#endif
#ifndef COLCH
#define COLCH 2
#endif
#ifndef F8MASK
#define F8MASK 15
#endif
#ifndef GSP2
#define GSP2 true
#endif
#ifndef GALIGN
#define GALIGN true
#endif
#ifndef RPT_MASK
#define RPT_MASK 0
#endif
#ifndef PHMASK
#define PHMASK 0x3fff
#endif

#define LAS __attribute__((address_space(3)))
typedef unsigned short bf16_t;
typedef short bf16x8 __attribute__((ext_vector_type(8)));
typedef float f32x4 __attribute__((ext_vector_type(4)));
typedef unsigned u32x4 __attribute__((ext_vector_type(4)));
typedef unsigned u32x2 __attribute__((ext_vector_type(2)));

constexpr int DM = 2048, NBATCH = 8, SEQ = 4096, DEPTH = 4, M = NBATCH * SEQ;
constexpr int DFF = 5632, NIN = 14848, MIXIN = 6656, BRT = 1792, NGATE = 8192;
constexpr float EPS = 1e-6f;
constexpr int AQ = 0, AF = 512, AI = 1024, AG = 1536, BQ = 2048, BKo = 2560, BVo = 3072, CQ = 3584, CKo = 4352, CVo = 5120, DQo = 5888, DKo = 6400, DVo = 6528;
constexpr int NCHUNK = M / 64;

constexpr size_t MiB = 1u << 20;
constexpr size_t WS_CTL = 0;
constexpr size_t WS_W13A = 1 * MiB;
constexpr size_t WS_W2A = WS_W13A + 44 * MiB;
constexpr size_t WS_WIN = WS_W2A + 22 * MiB;
constexpr size_t WS_WBR = WS_WIN + 58 * MiB;
constexpr size_t WS_WOUT = WS_WBR + 7 * MiB;
constexpr size_t WS_W13B = WS_WOUT + 8 * MiB;
constexpr size_t WS_W2B = WS_W13B + 44 * MiB;
constexpr size_t WS_WG8 = WS_W2B + 22 * MiB;
constexpr size_t WS_XN = WS_WG8 + 16 * MiB;
constexpr size_t WS_H16 = WS_XN + 128 * MiB;
constexpr size_t WS_R = WS_H16 + 128 * MiB;
constexpr size_t WS_ACT = WS_R;
constexpr size_t WS_F_FFN = WS_R + 352 * MiB;
constexpr size_t WS_PROJ = WS_R;
constexpr size_t WS_GATES = WS_R + 416 * MiB;
constexpr size_t WS_YALL = WS_GATES + 512 * MiB;
constexpr size_t WS_QI = WS_YALL + 112 * MiB;
constexpr size_t WS_OINTRA = WS_QI + 32 * MiB;
constexpr size_t WS_SPREV = WS_OINTRA + 64 * MiB;
constexpr size_t WS_DC = WS_SPREV + 64 * MiB;
constexpr size_t WS_CPART = WS_DC + 1 * MiB;
constexpr size_t WS_CLSE = WS_CPART + 48 * MiB;
constexpr size_t WS_END = WS_CLSE + 2 * MiB;
constexpr size_t WS_U = WS_XN;
constexpr size_t WS_MERGED = WS_PROJ;
constexpr size_t WS_F_MIX = WS_GATES;
constexpr size_t WS_XN8 = WS_XN;
constexpr float GATE_WSCALE = 32.0f;
constexpr int CW_BAR = 4096;

typedef _Float16 h16x2 __attribute__((ext_vector_type(2)));
typedef _Float16 h16x8 __attribute__((ext_vector_type(8)));
__device__ __forceinline__ unsigned cvt_pk_bf16(float lo, float hi) { h16x2 v; v.x = (_Float16)lo; v.y = (_Float16)hi; return __builtin_bit_cast(unsigned, v); }
__device__ __forceinline__ bf16_t f2bf(float f) { return __builtin_bit_cast(unsigned short, (_Float16)f); }
__device__ __forceinline__ float bf2f(bf16_t b) { return (float)__builtin_bit_cast(_Float16, b); }
__device__ __forceinline__ float bflo(unsigned w) { return (float)__builtin_bit_cast(h16x2, w).x; }
__device__ __forceinline__ float bfhi(unsigned w) { return (float)__builtin_bit_cast(h16x2, w).y; }
#define MFMA16(a, b, c) __builtin_amdgcn_mfma_f32_16x16x32_f16(__builtin_bit_cast(h16x8, (a)), __builtin_bit_cast(h16x8, (b)), (c), 0, 0, 0)
__device__ __forceinline__ unsigned cvt_pk_b16(float lo, float hi) { unsigned r; asm volatile("v_cvt_pk_bf16_f32 %0, %1, %2" : "=v"(r) : "v"(lo), "v"(hi)); return r; }
__device__ __forceinline__ bf16_t f2b16(float f) { return (bf16_t)(cvt_pk_b16(f, 0.f) & 0xffffu); }
__device__ __forceinline__ float b16lo(unsigned w) { return __uint_as_float(w << 16); }
__device__ __forceinline__ float b16hi(unsigned w) { return __uint_as_float(w & 0xffff0000u); }
#define MFMAB(a, b, c) __builtin_amdgcn_mfma_f32_16x16x32_bf16((a), (b), (c), 0, 0, 0)
typedef int v8i32 __attribute__((ext_vector_type(8)));
typedef int v4i32 __attribute__((ext_vector_type(4)));
__device__ __forceinline__ unsigned pk_fp8x4(float a, float b, float c, float d) { int w = __builtin_amdgcn_cvt_pk_fp8_f32(a, b, 0, false); w = __builtin_amdgcn_cvt_pk_fp8_f32(c, d, w, true); return (unsigned)w; }
__device__ __forceinline__ f32x4 mfma_fp8(const bf16x8 a0, const bf16x8 a1, const bf16x8 b0, const bf16x8 b1, const f32x4 c) {
    const u32x4 x0 = __builtin_bit_cast(u32x4, a0), x1 = __builtin_bit_cast(u32x4, a1), y0 = __builtin_bit_cast(u32x4, b0), y1 = __builtin_bit_cast(u32x4, b1);
    const v8i32 A = {(int)x0.x, (int)x0.y, (int)x0.z, (int)x0.w, (int)x1.x, (int)x1.y, (int)x1.z, (int)x1.w}, B = {(int)y0.x, (int)y0.y, (int)y0.z, (int)y0.w, (int)y1.x, (int)y1.y, (int)y1.z, (int)y1.w};
    return __builtin_amdgcn_mfma_scale_f32_16x16x128_f8f6f4(A, B, c, 0, 0, 0, 0x7f7f7f7f, 0, 0x7f7f7f7f);
}
__device__ __forceinline__ float wave_sum(float v) {
#pragma unroll
    for (int o = 1; o < 64; o <<= 1) v += __shfl_xor(v, o);
    return v;
}
__device__ __forceinline__ float fast_sigmoid(float x) { return __builtin_amdgcn_rcpf(1.0f + __expf(-x)); }
#define LDS_WAIT() asm volatile("s_waitcnt lgkmcnt(0)" ::: "memory")
template <int CTRL> __device__ __forceinline__ float dpp_f(float x) { return __builtin_bit_cast(float, __builtin_amdgcn_update_dpp(0, __builtin_bit_cast(int, x), CTRL, 0xf, 0xf, true)); }
__device__ __forceinline__ float row16_max(float v) { v = fmaxf(v, dpp_f<0xB1>(v)); v = fmaxf(v, dpp_f<0x4E>(v)); v = fmaxf(v, dpp_f<0x141>(v)); v = fmaxf(v, dpp_f<0x140>(v)); return v; }
__device__ __forceinline__ float row16_sum(float v) { v += dpp_f<0xB1>(v); v += dpp_f<0x4E>(v); v += dpp_f<0x141>(v); v += dpp_f<0x140>(v); return v; }

template <int TOFF> __device__ __forceinline__ void tr_frag4(unsigned addr, bf16x8 (&v)[4]) {
    u32x2 a0, a1, b0, b1, c0, c1, d0, d1;
    asm volatile("ds_read_b64_tr_b16 %0, %8\n\tds_read_b64_tr_b16 %1, %8 offset:%9\n\tds_read_b64_tr_b16 %2, %8 offset:32\n\tds_read_b64_tr_b16 %3, %8 offset:%10\n\t"
                 "ds_read_b64_tr_b16 %4, %8 offset:64\n\tds_read_b64_tr_b16 %5, %8 offset:%11\n\tds_read_b64_tr_b16 %6, %8 offset:96\n\tds_read_b64_tr_b16 %7, %8 offset:%12\n\ts_waitcnt lgkmcnt(0)"
                 : "=&v"(a0), "=&v"(a1), "=&v"(b0), "=&v"(b1), "=&v"(c0), "=&v"(c1), "=&v"(d0), "=&v"(d1) : "v"(addr), "n"(TOFF), "n"(TOFF + 32), "n"(TOFF + 64), "n"(TOFF + 96) : "memory");
    v[0] = __builtin_bit_cast(bf16x8, (u32x4){a0.x, a0.y, a1.x, a1.y}); v[1] = __builtin_bit_cast(bf16x8, (u32x4){b0.x, b0.y, b1.x, b1.y});
    v[2] = __builtin_bit_cast(bf16x8, (u32x4){c0.x, c0.y, c1.x, c1.y}); v[3] = __builtin_bit_cast(bf16x8, (u32x4){d0.x, d0.y, d1.x, d1.y});
}
__device__ __forceinline__ unsigned lds_addr(const LAS void* p) { return (unsigned)(size_t)p; }

#define XB_TMO      128
#define XB_XCNT(j)  (256  + 64 * (j))
#define XB_XSUB(j)  (1280 + 64 * (j))
#define XB_XGEN(j)  (2304 + 64 * (j))
#define XB_TOP      3328
#define XB_TOPGEN   3392
#define XCD_BAR_WORDS 3456
#define XB_SPIN_CAP (1u << 18)

__device__ __forceinline__ unsigned xb_ld(unsigned* p)              { return __hip_atomic_load(p, __ATOMIC_RELAXED, __HIP_MEMORY_SCOPE_AGENT); }
__device__ __forceinline__ unsigned xb_add(unsigned* p, unsigned v) { return __hip_atomic_fetch_add(p, v, __ATOMIC_RELAXED, __HIP_MEMORY_SCOPE_AGENT); }
__device__ __forceinline__ unsigned xb_xcc_id() { return (unsigned)__builtin_amdgcn_s_getreg((3 << 11) | 20) & 0xFu; }
#define XB_SPIN(cond, bar) do { unsigned _sp = 0; while (cond) { __builtin_amdgcn_s_sleep(1); \
    if ((++_sp & 255u) == 0u) { if (xb_ld(&(bar)[XB_TMO])) break; if (_sp > XB_SPIN_CAP) { atomicAdd(&(bar)[XB_TMO], 1u); break; } } } } while (0)

struct XcdBarrier { unsigned* bar; unsigned x; volatile LAS unsigned* st; };

__device__ __forceinline__ XcdBarrier xcd_barrier_post(unsigned* bar, volatile LAS unsigned* st) {
    XcdBarrier b; b.bar = bar; b.x = xb_xcc_id(); b.st = st;
    if (threadIdx.x == 0) (void)xb_add(&bar[XB_XCNT(b.x)], 1u);
    return b;
}
__device__ __forceinline__ void xcd_barrier_complete(unsigned* bar, unsigned x, unsigned& nloc, unsigned& nx) {
    const unsigned G = gridDim.x * gridDim.y * gridDim.z;
    unsigned sum, cnt, mine, sp = 0u;
    for (;;) {
        sum = 0u; cnt = 0u; mine = 0u;
#pragma unroll
        for (unsigned j = 0; j < 16; ++j) { const unsigned c = xb_ld(&bar[XB_XCNT(j)]); sum += c; cnt += (c > 0u) ? 1u : 0u; mine = (j == x) ? c : mine; }
        if (sum == G) break;
        __builtin_amdgcn_s_sleep(1);
        if ((++sp & 255u) == 0u) { if (xb_ld(&bar[XB_TMO])) break; if (sp > XB_SPIN_CAP) { atomicAdd(&bar[XB_TMO], 1u); break; } }
    }
    nloc = mine > 0u ? mine : 1u; nx = cnt > 0u ? cnt : 1u;
}
__device__ __forceinline__ void xcd_barrier(const XcdBarrier& b) {
    asm volatile("s_waitcnt vmcnt(0)" ::: "memory");
    __syncthreads();
    if (threadIdx.x == 0) {
        unsigned* bar = b.bar;
        __builtin_amdgcn_s_waitcnt(0);
        unsigned nloc = b.st[0], nx = b.st[1];
        if (nloc == 0u) { xcd_barrier_complete(bar, b.x, nloc, nx); b.st[0] = nloc; b.st[1] = nx; }
        const unsigned old = xb_add(&bar[XB_XSUB(b.x)], 1u);
        const unsigned gen = old / nloc;
        if (old + 1u == (gen + 1u) * nloc) {
            __builtin_amdgcn_fence(__ATOMIC_RELEASE, "agent");
            asm volatile("s_waitcnt vmcnt(0)" ::: "memory");
            const unsigned og = xb_add(&bar[XB_TOP], 1u);
            const unsigned tg = og / nx;
            if (og + 1u == (tg + 1u) * nx) xb_add(&bar[XB_TOPGEN], 1u);
            else XB_SPIN(xb_ld(&bar[XB_TOPGEN]) == tg, bar);
            __builtin_amdgcn_fence(__ATOMIC_ACQUIRE, "agent");
            xb_add(&bar[XB_XGEN(b.x)], 1u);
            asm volatile("s_waitcnt vmcnt(0)" ::: "memory");
        } else {
            XB_SPIN(xb_ld(&bar[XB_XGEN(b.x)]) == gen, bar);
            __builtin_amdgcn_fence(__ATOMIC_ACQUIRE, "agent");
            asm volatile("s_waitcnt vmcnt(0)" ::: "memory");
        }
    }
    __syncthreads();
}

namespace pg8 {
constexpr int BM = 256, BK = 64, HALF = 128, HTB = HALF * BK * 2, STAGE_BYTES = 8 * HTB, NXCD = 8, WGM = 4;
__device__ __forceinline__ int lds_byte(int r, int c) { const int st = (r >> 4) * 2 + (c >> 5), rr = r & 15, cc = c & 31, ob = rr * 64 + cc * 2; return st * 1024 + (ob ^ (((ob >> 9) & 1) << 5)); }
__device__ __forceinline__ void stage_rc(int b, int& R, int& C) { const int st = b / 1024, sb = b % 1024, swz = sb ^ (((sb >> 9) & 1) << 5); R = (st >> 1) * 16 + swz / 64; C = (st & 1) * 32 + (swz % 64) / 2; }
__device__ __forceinline__ int perm32(int rho) { const int n = rho >> 4, i = rho & 15; return 8 * (i >> 2) + 4 * n + (i & 3); }

struct Unit { int pm, pn, aux, nt; const char* A; const char* B; };

struct TileOrder {
    int nM, nN, nwg, G, c, rev;
    __device__ __forceinline__ void init(int nM_, int nN_, int G_, int c_, int rev_ = 0) { nM = nM_; nN = nN_; nwg = nM * nN; G = G_; c = c_; rev = rev_; }
    __device__ __forceinline__ bool tile(int i, int& pm, int& pn) const {
        const long L = (long)i * G + c; if (L >= nwg) return false;
        int wgid = (int)L; { const int q = nwg / NXCD, r = nwg % NXCD, xcd = wgid % NXCD; int off = wgid / NXCD; if ((rev & 1) && r == 0) off = q - 1 - off;
            wgid = (xcd < r ? xcd * (q + 1) : r * (q + 1) + (xcd - r) * q) + off; }
        if (rev & 2) {
            const int nig = WGM * nM, gid = wgid / nig, fn = gid * WGM, gsz = (nN - fn) < WGM ? (nN - fn) : WGM;
            pn = fn + ((wgid % nig) % gsz); pm = (wgid % nig) / gsz; return true; }
        const int nig = WGM * nN, gid = wgid / nig, fm = gid * WGM, gsz = (nM - fm) < WGM ? (nM - fm) : WGM;
        pm = fm + ((wgid % nig) % gsz); pn = (wgid % nig) / gsz; return true;
    }
};
struct SchedPlain {
    TileOrder o; const char* A; const char* B; size_t tstepA, tstepB; int nt; int bmap = -1;
    __device__ __forceinline__ bool next(int i, Unit& u) const {
        if (!o.tile(i, u.pm, u.pn)) return false;
        if (bmap >= 0) u.pn = 8 * ((bmap >> (4 * (u.pn >> 3))) & 15) + (u.pn & 7);
        u.A = A + (size_t)u.pm * tstepA; u.B = B + (size_t)u.pn * tstepB; u.nt = nt; u.aux = 0; return true;
    }
};
struct SchedBranch {
    TileOrder o; const char* A; const char* B; size_t tstepA, tstepB;
    __device__ __forceinline__ bool next(int i, Unit& u) const {
        if (!o.tile(i >> 2, u.pm, u.pn)) return false;
        const int br = i & 3; const int koff = br == 0 ? 0 : (br == 1 ? 512 : (br == 2 ? 1024 : 1280));
        u.A = A + (size_t)u.pm * tstepA + (size_t)koff * 2; u.B = B + (size_t)u.pn * tstepB + (size_t)koff * 2; u.nt = (br == 2) ? 4 : 8; u.aux = br; return true;
    }
};

struct EpiBf16 {
    bf16_t* O; int ldc;
    __device__ __forceinline__ bool operator()(f32x4 (&acc)[2][2][4][2], const Unit& u, int wr, int wc, int fr, int fq) const {
        const int row0 = u.pm * BM + wr * 64 + fr, col0 = u.pn * BM + wc * 32 + 8 * fq;
#pragma unroll
        for (int ai = 0; ai < 2; ++ai)
#pragma unroll
            for (int m = 0; m < 4; ++m) { bf16_t* rowp = O + (size_t)(row0 + ai * HALF + m * 16) * ldc + col0;
#pragma unroll
                for (int bj = 0; bj < 2; ++bj) { const f32x4 v0 = acc[ai][bj][m][0], v1 = acc[ai][bj][m][1];
                    u32x4 w; w.x = cvt_pk_bf16(v0[0], v0[1]); w.y = cvt_pk_bf16(v0[2], v0[3]); w.z = cvt_pk_bf16(v1[0], v1[1]); w.w = cvt_pk_bf16(v1[2], v1[3]);
                    *(u32x4*)(rowp + bj * HALF) = w; } }
        return true;
    }
};
struct EpiSwiglu {
    bf16_t* O; int ldc;
    __device__ __forceinline__ bool operator()(f32x4 (&acc)[2][2][4][2], const Unit& u, int wr, int wc, int fr, int fq) const {
        typedef float f32x2 __attribute__((ext_vector_type(2)));
        const int row0 = u.pm * BM + wr * 64 + fr, col0 = u.pn * HALF + wc * 32 + 8 * fq;
#pragma unroll
        for (int ai = 0; ai < 2; ++ai)
#pragma unroll
            for (int m = 0; m < 4; ++m) { bf16_t* rowp = O + (size_t)(row0 + ai * HALF + m * 16) * ldc + col0;
                unsigned w[4];
#pragma unroll
                for (int n = 0; n < 2; ++n)
#pragma unroll
                    for (int jp = 0; jp < 2; ++jp) { const f32x2 g = {acc[ai][0][m][n][2 * jp], acc[ai][0][m][n][2 * jp + 1]}, up = {acc[ai][1][m][n][2 * jp], acc[ai][1][m][n][2 * jp + 1]};
                        f32x2 e; e.x = __builtin_amdgcn_exp2f(g.x); e.y = __builtin_amdgcn_exp2f(g.y);
                        const f32x2 d = e + 1.0f; f32x2 r; r.x = __builtin_amdgcn_rcpf(d.x); r.y = __builtin_amdgcn_rcpf(d.y);
                        const f32x2 h = (g * up) * r; w[n * 2 + jp] = cvt_pk_b16(h.x, h.y); }
                *(u32x4*)rowp = (u32x4){w[0], w[1], w[2], w[3]}; }
        return true;
    }
};
struct EpiInproj {
    bf16_t* P; bf16_t* Gt;
    __device__ __forceinline__ bool operator()(f32x4 (&acc)[2][2][4][2], const Unit& u, int wr, int wc, int fr, int fq) const {
        const int row0 = u.pm * BM + wr * 64 + fr; const bool isg = u.pn >= 26;
        bf16_t* base = isg ? Gt : P; const int ldc = isg ? NGATE : MIXIN; const int col0 = (isg ? (u.pn - 26) : u.pn) * BM + wc * 32 + 8 * fq;
#pragma unroll
        for (int ai = 0; ai < 2; ++ai)
#pragma unroll
            for (int m = 0; m < 4; ++m) { bf16_t* rowp = base + (size_t)(row0 + ai * HALF + m * 16) * ldc + col0;
#pragma unroll
                for (int bj = 0; bj < 2; ++bj) { f32x4 v0 = acc[ai][bj][m][0], v1 = acc[ai][bj][m][1];
                    if (isg) {
#pragma unroll
                        for (int j = 0; j < 4; ++j) { v0[j] = fminf(1.0f + __expf(-v0[j]), 60000.0f); v1[j] = fminf(1.0f + __expf(-v1[j]), 60000.0f); } }
                    u32x4 w; w.x = cvt_pk_bf16(v0[0], v0[1]); w.y = cvt_pk_bf16(v0[2], v0[3]); w.z = cvt_pk_bf16(v1[0], v1[1]); w.w = cvt_pk_bf16(v1[2], v1[3]);
                    *(u32x4*)(rowp + bj * HALF) = w; } }
        return true;
    }
};
struct EpiGates {
    unsigned char* Gt; float inv;
    __device__ __forceinline__ bool operator()(f32x4 (&acc)[2][2][4][2], const Unit& u, int wr, int wc, int fr, int fq) const {
        const int row0 = u.pm * BM + wr * 64 + fr, col0 = u.pn * BM + wc * 64 + 16 * fq; const float ninv2 = -inv * 1.44269504089f;
#pragma unroll
        for (int ai = 0; ai < 2; ++ai)
#pragma unroll
            for (int m = 0; m < 4; ++m) { unsigned char* rowp = Gt + (size_t)(row0 + ai * HALF + m * 16) * NGATE + col0; unsigned wq[4];
#pragma unroll
                for (int bj = 0; bj < 2; ++bj) { const f32x4 v0 = acc[ai][bj][m][0] * ninv2, v1 = acc[ai][bj][m][1] * ninv2;
                    f32x4 e0, e1;
#pragma unroll
                    for (int j = 0; j < 4; ++j) { e0[j] = fminf(__builtin_amdgcn_exp2f(v0[j]), 500.0f); e1[j] = fminf(__builtin_amdgcn_exp2f(v1[j]), 500.0f); }
                    e0 = e0 + 1.0f; e1 = e1 + 1.0f;
                    f32x4 g0, g1;
#pragma unroll
                    for (int j = 0; j < 4; ++j) { g0[j] = __builtin_amdgcn_rcpf(e0[j]); g1[j] = __builtin_amdgcn_rcpf(e1[j]); }
                    g0 = g0 * 255.0f; g1 = g1 * 255.0f;
                    unsigned w0 = 0u, w1 = 0u;
#pragma unroll
                    for (int j = 0; j < 4; ++j) { w0 = __builtin_amdgcn_cvt_pk_u8_f32(__builtin_rintf(g0[j]), j, w0); w1 = __builtin_amdgcn_cvt_pk_u8_f32(__builtin_rintf(g1[j]), j, w1); }
                    wq[2 * bj] = w0; wq[2 * bj + 1] = w1; }
                *(u32x4*)rowp = (u32x4){wq[0], wq[1], wq[2], wq[3]}; }
        return true;
    }
};
struct EpiBranch {
    bf16_t* Mg; const unsigned char* Gt;
    __device__ __forceinline__ void apply(f32x4 (&acc)[2][2][4][2], int ai, int m, int bj, const u32x2 c8, const u32x2 n8, int br, size_t off) const {
        f32x4 v0 = acc[ai][bj][m][0], v1 = acc[ai][bj][m][1];
#define UB(w, k) ((float)(((w) >> (8 * (k))) & 0xffu))
        v0[0] *= UB(c8.x, 0) * __builtin_amdgcn_rcpf(UB(n8.x, 0)); v0[1] *= UB(c8.x, 1) * __builtin_amdgcn_rcpf(UB(n8.x, 1));
        v0[2] *= UB(c8.x, 2) * __builtin_amdgcn_rcpf(UB(n8.x, 2)); v0[3] *= UB(c8.x, 3) * __builtin_amdgcn_rcpf(UB(n8.x, 3));
        v1[0] *= UB(c8.y, 0) * __builtin_amdgcn_rcpf(UB(n8.y, 0)); v1[1] *= UB(c8.y, 1) * __builtin_amdgcn_rcpf(UB(n8.y, 1));
        v1[2] *= UB(c8.y, 2) * __builtin_amdgcn_rcpf(UB(n8.y, 2)); v1[3] *= UB(c8.y, 3) * __builtin_amdgcn_rcpf(UB(n8.y, 3));
#undef UB
        if (br < 3) { acc[ai][bj][m][0] = v0; acc[ai][bj][m][1] = v1; }
        else { u32x4 w; w.x = cvt_pk_b16(v0[0], v0[1]); w.y = cvt_pk_b16(v0[2], v0[3]); w.z = cvt_pk_b16(v1[0], v1[1]); w.w = cvt_pk_b16(v1[2], v1[3]); *(u32x4*)(Mg + off) = w; }
    }
    __device__ __forceinline__ bool operator()(f32x4 (&acc)[2][2][4][2], const Unit& u, int wr, int wc, int fr, int fq) const {
        const int row0 = u.pm * BM + wr * 64 + fr, col0 = u.pn * BM + wc * 32 + 8 * fq, gcol = u.pn * BM + wc * 64 + 16 * fq; const int br = u.aux;
        const u32x4 one = (u32x4){0xffffffffu, 0xffffffffu, 0xffffffffu, 0xffffffffu};
        u32x4 ec[3], en[3];
#define EB_LOAD(buf, q) do { const unsigned char* gp = Gt + (size_t)(row0 + ((q) >> 2) * HALF + ((q) & 3) * 16) * NGATE + (size_t)br * DM + gcol; \
            ec[buf] = *(const u32x4*)gp; en[buf] = one; if (br < 3) en[buf] = *(const u32x4*)(gp + DM); } while (0)
#define EB_APPLY(buf, q) do { const size_t off_ = (size_t)(row0 + ((q) >> 2) * HALF + ((q) & 3) * 16) * DM + col0; \
            apply(acc, (q) >> 2, (q) & 3, 0, (u32x2){ec[buf].x, ec[buf].y}, (u32x2){en[buf].x, en[buf].y}, br, off_); \
            apply(acc, (q) >> 2, (q) & 3, 1, (u32x2){ec[buf].z, ec[buf].w}, (u32x2){en[buf].z, en[buf].w}, br, off_ + HALF); } while (0)
        EB_LOAD(0, 0); asm volatile("" ::: "memory");
        EB_LOAD(1, 1); asm volatile("" ::: "memory");
        EB_LOAD(2, 2); asm volatile("" ::: "memory");
        EB_APPLY(0, 0); asm volatile("" ::: "memory"); EB_LOAD(0, 3); asm volatile("" ::: "memory");
        EB_APPLY(1, 1); asm volatile("" ::: "memory"); EB_LOAD(1, 4); asm volatile("" ::: "memory");
        EB_APPLY(2, 2); asm volatile("" ::: "memory"); EB_LOAD(2, 5); asm volatile("" ::: "memory");
        EB_APPLY(0, 3); asm volatile("" ::: "memory"); EB_LOAD(0, 6); asm volatile("" ::: "memory");
        EB_APPLY(1, 4); asm volatile("" ::: "memory"); EB_LOAD(1, 7); asm volatile("" ::: "memory");
        EB_APPLY(2, 5); asm volatile("" ::: "memory");
        EB_APPLY(0, 6); asm volatile("" ::: "memory");
        EB_APPLY(1, 7); asm volatile("" ::: "memory");
#undef EB_LOAD
#undef EB_APPLY
        return br == 3;
    }
};

template <bool F8 = false, bool SP2 = false, bool ALIGN = false, class Epi, class Sched>
__device__ __forceinline__ void gemm_phase(LAS unsigned char* lds, const int lda, const int ldb, const Sched& S, const Epi& E) {
    int tid_ = threadIdx.x; asm volatile("" : "+v"(tid_));
    const int tid = tid_, wid = __builtin_amdgcn_readfirstlane(tid >> 6), lane = tid & 63, wr = wid >> 2, wc = wid & 3, fr = lane & 15, fq = lane >> 4;
    unsigned voffA[2], voffB[2];
#pragma unroll
    for (int i = 0; i < 2; ++i) { int R, C; stage_rc(tid * 16 + i * 8192, R, C); const int Rb = (R & ~31) + perm32(R & 31);
        voffA[i] = (unsigned)(R * lda + C) * 2u; voffB[i] = (unsigned)(Rb * ldb + C) * 2u; }
    const size_t kstep = (size_t)(BK * 2);
    const size_t hstepA = (size_t)HALF * lda * 2, hstepB = (size_t)HALF * ldb * 2;
    const unsigned ldsw = (unsigned)wid * 1024u;
    const int aoff = lds_byte(wr * 64 + fr, fq * 8), boff = lds_byte(wc * 32 + fr, fq * 8);
#define PG8_SA(b, h) (((b) * 2 + (h)) * HTB)
#define PG8_SB(b, h) ((4 + (b) * 2 + (h)) * HTB)
#define PG8_STAGE(bufoff, gbase, voff) do { _Pragma("unroll") for (int _i = 0; _i < 2; ++_i) \
        __builtin_amdgcn_global_load_lds((const unsigned*)((const char*)(gbase) + (voff)[_i]), (LAS unsigned*)(lds + (bufoff) + ldsw + _i * 8192), 16, 0, 0); } while (0)
#define PG8_LDA(dst, b, h) do { if constexpr (F8) { _Pragma("unroll") for (int m = 0; m < 4; ++m) { A8[m].lo = *(const LAS v4i32*)(lds + PG8_SA(b, h) + aoff + m * 2048); A8[m].hi = *(const LAS v4i32*)(lds + PG8_SA(b, h) + aoff + m * 2048 + 1024); } } \
        else { _Pragma("unroll") for (int m = 0; m < 4; ++m) _Pragma("unroll") for (int k = 0; k < 2; ++k) dst[m][k] = *(const LAS bf16x8*)(lds + PG8_SA(b, h) + aoff + m * 2048 + k * 1024); } } while (0)
#define PG8_LDB(dst, b, h) do { if constexpr (F8) { _Pragma("unroll") for (int n = 0; n < 2; ++n) { dst##8[n].lo = *(const LAS v4i32*)(lds + PG8_SB(b, h) + boff + n * 2048); dst##8[n].hi = *(const LAS v4i32*)(lds + PG8_SB(b, h) + boff + n * 2048 + 1024); } } \
        else { _Pragma("unroll") for (int n = 0; n < 2; ++n) _Pragma("unroll") for (int k = 0; k < 2; ++k) dst[n][k] = *(const LAS bf16x8*)(lds + PG8_SB(b, h) + boff + n * 2048 + k * 1024); } } while (0)
#define PG8_MMA(ai, bj, At, Bt) do { __builtin_amdgcn_s_setprio(1); _Pragma("unroll") for (int m = 0; m < 4; ++m) _Pragma("unroll") for (int n = 0; n < 2; ++n) { \
        if constexpr (F8) asm volatile("v_mfma_scale_f32_16x16x128_f8f6f4 %0, %1, %2, %0, %3, %3 op_sel_hi:[0,0,0]" : "+v"(acc[ai][bj][m][n]) : "v"(Bt##8[n]), "v"(A8[m]), "v"(sc8)); \
        else { _Pragma("unroll") for (int k = 0; k < 2; ++k) acc[ai][bj][m][n] = MFMAB(Bt[n][k], At[m][k], acc[ai][bj][m][n]); } } __builtin_amdgcn_s_setprio(0); } while (0)
#define PG8_WAIT_V(n) asm volatile("s_waitcnt vmcnt(" #n ")" ::: "memory")
#define PG8_WAIT_L(n) asm volatile("s_waitcnt lgkmcnt(" #n ")" ::: "memory")
#define PG8_BAR __builtin_amdgcn_s_barrier()
#define PG8_SCHED __builtin_amdgcn_sched_barrier(0)
    Unit cur, nxt; int ui = 0;
    if (!S.next(0, cur)) return;
    f32x4 acc[2][2][4][2];
#pragma unroll
    for (int a = 0; a < 2; ++a)
#pragma unroll
        for (int b = 0; b < 2; ++b)
#pragma unroll
            for (int m = 0; m < 4; ++m)
#pragma unroll
                for (int n = 0; n < 2; ++n) acc[a][b][m][n] = (f32x4){0.f, 0.f, 0.f, 0.f};
    bf16x8 At[4][2], B0[2][2], B1[2][2];
    v8i32 A8[4], B08[2], B18[2];
    const int sc8 = 0x7f7f7f7f;
    const char* cA = cur.A; const char* cB = cur.B; int nt = cur.nt;
    if constexpr (SP2) {
        PG8_STAGE(PG8_SB(0, 0), cB, voffB); PG8_STAGE(PG8_SB(0, 1), cB + hstepB, voffB); PG8_STAGE(PG8_SA(0, 0), cA, voffA); PG8_STAGE(PG8_SA(0, 1), cA + hstepA, voffA);
        if (wr == 1) PG8_BAR;
        PG8_WAIT_V(2); PG8_BAR;
        PG8_STAGE(PG8_SB(1, 0), cB + kstep, voffB); PG8_STAGE(PG8_SA(1, 0), cA + kstep, voffA); PG8_STAGE(PG8_SB(1, 1), cB + hstepB + kstep, voffB);
        PG8_WAIT_V(6); PG8_BAR;
    } else {
    PG8_STAGE(PG8_SB(0, 0), cB, voffB); PG8_STAGE(PG8_SA(0, 0), cA, voffA); PG8_STAGE(PG8_SB(0, 1), cB + hstepB, voffB); PG8_STAGE(PG8_SA(0, 1), cA + hstepA, voffA);
    if (wr == 1) PG8_BAR;
    PG8_WAIT_V(4); PG8_BAR;
    PG8_STAGE(PG8_SB(1, 0), cB + kstep, voffB); PG8_STAGE(PG8_SA(1, 0), cA + kstep, voffA); PG8_STAGE(PG8_SB(1, 1), cB + hstepB + kstep, voffB);
    PG8_WAIT_V(6); PG8_BAR;
    }
    for (;;) {
        const bool has_next = S.next(ui + 1, nxt);
        const char* nA = has_next ? nxt.A : cA; const char* nB = has_next ? nxt.B : cB;
        for (int t = 0; t < nt; t += 2) {
            const bool last = (t == nt - 2);
            const char* a1 = cA + (size_t)(t + 1) * kstep;
            const char* a2 = last ? nA : cA + (size_t)(t + 2) * kstep; const char* b2 = last ? nB : cB + (size_t)(t + 2) * kstep;
            const char* a3 = a2 + kstep; const char* b3 = b2 + kstep;
            if constexpr (SP2) {
            PG8_LDB(B0, 0, 0); PG8_LDB(B1, 0, 1); PG8_SCHED; PG8_LDA(At, 0, 0); PG8_STAGE(PG8_SA(1, 1), a1 + hstepA, voffA);
            PG8_WAIT_V(8); PG8_WAIT_L(0); PG8_BAR; PG8_MMA(0, 0, At, B0); PG8_MMA(0, 1, At, B1); PG8_BAR; PG8_SCHED;
            PG8_LDA(At, 0, 1); PG8_STAGE(PG8_SB(0, 0), b2, voffB); PG8_STAGE(PG8_SB(0, 1), b2 + hstepB, voffB); PG8_STAGE(PG8_SA(0, 0), a2, voffA);
            PG8_WAIT_V(8); PG8_WAIT_L(0); PG8_BAR; PG8_MMA(1, 0, At, B0); PG8_MMA(1, 1, At, B1); PG8_BAR; PG8_SCHED;
            PG8_LDB(B0, 1, 0); PG8_LDB(B1, 1, 1); PG8_SCHED; PG8_LDA(At, 1, 0); PG8_STAGE(PG8_SA(0, 1), a2 + hstepA, voffA);
            PG8_WAIT_V(8); PG8_WAIT_L(0); PG8_BAR; PG8_MMA(0, 0, At, B0); PG8_MMA(0, 1, At, B1); PG8_BAR; PG8_SCHED;
            PG8_LDA(At, 1, 1); PG8_STAGE(PG8_SB(1, 0), b3, voffB); PG8_STAGE(PG8_SB(1, 1), b3 + hstepB, voffB); PG8_STAGE(PG8_SA(1, 0), a3, voffA);
            PG8_WAIT_V(8); PG8_WAIT_L(0); PG8_BAR; PG8_MMA(1, 0, At, B0); PG8_MMA(1, 1, At, B1); PG8_BAR; PG8_SCHED;
            } else {
            PG8_LDB(B0, 0, 0); PG8_SCHED; PG8_LDA(At, 0, 0); PG8_STAGE(PG8_SA(1, 1), a1 + hstepA, voffA);
            PG8_WAIT_L(8); PG8_BAR; PG8_WAIT_L(0); PG8_MMA(0, 0, At, B0); PG8_BAR; PG8_SCHED;
            PG8_LDB(B1, 0, 1); PG8_STAGE(PG8_SB(0, 0), b2, voffB);
            PG8_BAR; PG8_WAIT_L(0); PG8_MMA(0, 1, At, B1); PG8_BAR;
            PG8_LDA(At, 0, 1); PG8_STAGE(PG8_SA(0, 0), a2, voffA);
            PG8_BAR; PG8_WAIT_L(0); PG8_MMA(1, 0, At, B0); PG8_BAR; PG8_SCHED;
            PG8_STAGE(PG8_SB(0, 1), b2 + hstepB, voffB);
            PG8_WAIT_V(6); PG8_BAR; PG8_MMA(1, 1, At, B1); PG8_BAR;
            PG8_LDB(B0, 1, 0); PG8_SCHED; PG8_LDA(At, 1, 0); PG8_STAGE(PG8_SA(0, 1), a2 + hstepA, voffA);
            PG8_WAIT_L(8); PG8_BAR; PG8_WAIT_L(0); PG8_MMA(0, 0, At, B0); PG8_BAR; PG8_SCHED;
            PG8_LDB(B1, 1, 1); PG8_STAGE(PG8_SB(1, 0), b3, voffB);
            PG8_BAR; PG8_WAIT_L(0); PG8_MMA(0, 1, At, B1); PG8_BAR;
            PG8_LDA(At, 1, 1); PG8_STAGE(PG8_SA(1, 0), a3, voffA);
            PG8_BAR; PG8_WAIT_L(0); PG8_MMA(1, 0, At, B0); PG8_BAR; PG8_SCHED;
            PG8_STAGE(PG8_SB(1, 1), b3 + hstepB, voffB);
            PG8_WAIT_V(6); PG8_BAR; PG8_MMA(1, 1, At, B1); PG8_BAR;
            }
        }
        if constexpr (ALIGN) { if (wr == 0) PG8_BAR; }
        const bool consumed = E(acc, cur, wr, wc, fr, fq);
        if (!has_next) break;
        if (consumed)
#pragma unroll
        for (int a = 0; a < 2; ++a)
#pragma unroll
            for (int b = 0; b < 2; ++b)
#pragma unroll
                for (int m = 0; m < 4; ++m)
#pragma unroll
                    for (int n = 0; n < 2; ++n) acc[a][b][m][n] = (f32x4){0.f, 0.f, 0.f, 0.f};
        cur = nxt; cA = nA; cB = nB; nt = cur.nt; ++ui;
        if constexpr (ALIGN) { if (wr == 1) PG8_BAR; }
    }
    PG8_WAIT_V(0);
    if constexpr (!ALIGN) { if (wr == 0) PG8_BAR; }
    PG8_BAR;
#undef PG8_SA
#undef PG8_SB
#undef PG8_STAGE
#undef PG8_LDA
#undef PG8_LDB
#undef PG8_MMA
#undef PG8_WAIT_V
#undef PG8_WAIT_L
#undef PG8_BAR
#undef PG8_SCHED
}
}

constexpr int branch_list(int mask) { int r = 0, n = 0; for (int b = 0; b < 4; ++b) if ((mask >> b) & 1) { r |= b << (4 * n); ++n; } return r; }
struct Args {
    const float* x; const float* ffn1_norm; const float* ffn1_w13; const float* ffn1_w2; const float* mix_norm; const float* w_in; const float* lb_logits; const float* hgrn_norm;
    const float* sinks; const float* w_branch; const float* w_out; const float* ffn2_norm; const float* ffn2_w13; const float* ffn2_w2; const float* rel_bias;
    float* out; unsigned char* ws;
    int l_lo, l_hi, ph_lo, ph_hi;
};

struct ConvDesc { const float* W; const float* gk; bf16_t* WT; unsigned char* W8; int K, N, k0, n0, drow0; float wscale; };
__device__ __forceinline__ ConvDesc conv_desc(const Args& a, int l, int it) {
    unsigned char* ws = a.ws;
    constexpr int I13 = (DM / 128) * (2 * DFF / 64), I2 = (DFF / 128) * (DM / 64), IIN = (DM / 128) * (NIN / 64), IBR = (BRT / 128) * (DM / 64);
    ConvDesc d; d.gk = nullptr; d.W8 = nullptr; d.WT = nullptr; d.wscale = 1.0f;
    int r = it;
    if (r < 2 * I13) {
        const bool second = r >= I13; if (second) r -= I13;
        d.W = (second ? a.ffn2_w13 : a.ffn1_w13) + (size_t)l * DM * 2 * DFF; d.WT = (bf16_t*)(ws + (second ? WS_W13B : WS_W13A));
        const int nblk = 2 * DFF / 64, kb = r / nblk, nb = r % nblk, n0 = 64 * nb;
        const int isup = n0 >= DFF; const int j = isup ? n0 - DFF : n0;
        d.K = DM; d.N = 2 * DFF; d.k0 = 128 * kb; d.n0 = n0; d.drow0 = 256 * (j / 128) + (isup ? 128 : 0) + (j % 128);
        d.gk = (second ? a.ffn2_norm : a.ffn1_norm) + (size_t)(l * 2) * DM; d.wscale = __uint_as_float((unsigned)__builtin_amdgcn_readfirstlane((int)(isup ? 0xbf317218u : 0xbfb8aa3bu))); return d; }
    r -= 2 * I13;
    if (r < 2 * I2) {
        const bool second = r >= I2; if (second) r -= I2;
        d.W = (second ? a.ffn2_w2 : a.ffn1_w2) + (size_t)l * DFF * DM; d.WT = (bf16_t*)(ws + (second ? WS_W2B : WS_W2A));
        const int nblk = DM / 64, kb = r / nblk, nb = r % nblk;
        d.K = DFF; d.N = DM; d.k0 = 128 * kb; d.n0 = 64 * nb; d.drow0 = 64 * nb; return d; }
    r -= 2 * I2;
    if (r < IIN) { const int nblk = NIN / 64, kb = r / nblk, nb = r % nblk;
        d.W = a.w_in + (size_t)l * DM * NIN; d.K = DM; d.N = NIN; d.k0 = 128 * kb; d.n0 = 64 * nb; d.gk = a.mix_norm + (size_t)(l * 2) * DM;
        if (64 * nb >= MIXIN && ((F8MASK >> ((64 * nb - MIXIN) / DM)) & 1)) { d.W8 = ws + WS_WG8; d.drow0 = 64 * nb - MIXIN; d.wscale = GATE_WSCALE; }
        else { d.WT = (bf16_t*)(ws + WS_WIN); d.drow0 = 64 * nb; }
        return d; }
    r -= IIN;
    if (r < IBR) { const int nblk = DM / 64, kb = r / nblk, nb = r % nblk;
        d.W = a.w_branch + (size_t)l * BRT * DM; d.WT = (bf16_t*)(ws + WS_WBR); d.K = BRT; d.N = DM; d.k0 = 128 * kb; d.n0 = 64 * nb; d.drow0 = 64 * nb; return d; }
    r -= IBR;
    { const int nblk = DM / 64, kb = r / nblk, nb = r % nblk;
        d.W = a.w_out + (size_t)l * DM * DM; d.WT = (bf16_t*)(ws + WS_WOUT); d.K = DM; d.N = DM; d.k0 = 128 * kb; d.n0 = 64 * nb; d.drow0 = 64 * nb; return d; }
}
__device__ __forceinline__ void conv_load(const ConvDesc& d, float (&v)[16], int wave, int lane) {
#pragma unroll
    for (int i = 0; i < 16; ++i) { const int k = d.k0 + wave * 16 + i; v[i] = d.W[(size_t)k * d.N + d.n0 + lane] * ((d.gk ? d.gk[k] : 1.0f) * d.wscale); }
}
__device__ __forceinline__ void convert_weights(const Args& a, int l, LAS unsigned char* lds, int bid, int G, int lane, int wave) {
    LAS float* tile = (LAS float*)lds;
    constexpr int I13 = (DM / 128) * (2 * DFF / 64), I2 = (DFF / 128) * (DM / 64), IIN = (DM / 128) * (NIN / 64), IBR = (BRT / 128) * (DM / 64), IOUT = (DM / 128) * (DM / 64);
    constexpr int NITEMS = 2 * I13 + 2 * I2 + IIN + IBR + IOUT;
    asm volatile("" : "+s"(bid));
    if (bid >= NITEMS) return;
    float v[16];
    { const ConvDesc d0 = conv_desc(a, l, bid); conv_load(d0, v, wave, lane); }
    for (int it = bid; it < NITEMS; it += G) {
        __syncthreads();
#pragma unroll
        for (int i = 0; i < 16; ++i) tile[(wave * 16 + i) * 65 + lane] = v[i];
        __syncthreads();
        if (it + G < NITEMS) { const ConvDesc dn = conv_desc(a, l, it + G); conv_load(dn, v, wave, lane); }
        const ConvDesc c = conv_desc(a, l, it);
#pragma unroll
        for (int j = 0; j < 8; ++j) { const int n = wave * 8 + j; const float lo = tile[(2 * lane) * 65 + n], hi = tile[(2 * lane + 1) * 65 + n];
            if (c.W8) *(unsigned short*)(c.W8 + (size_t)(c.drow0 + n) * c.K + c.k0 + 2 * lane) = (unsigned short)(__builtin_amdgcn_cvt_pk_fp8_f32(lo, hi, 0, false) & 0xffff);
            else *(unsigned*)(c.WT + (size_t)(c.drow0 + n) * c.K + c.k0 + 2 * lane) = cvt_pk_b16(lo, hi); }
    }
}

__device__ __forceinline__ void prenorm_rows(const float* x, bf16_t* xn, float* rstd_out, int gw, int NGW, int lane) {
    for (int m = gw; m < M; m += NGW) {
        const float* xr = x + (size_t)m * DM; float v[32]; float ss = 0.f;
#pragma unroll
        for (int j = 0; j < 4; ++j) { const f32x4 a0 = *(const f32x4*)(xr + 512 * j + 8 * lane), a1 = *(const f32x4*)(xr + 512 * j + 8 * lane + 4);
#pragma unroll
            for (int e = 0; e < 4; ++e) { v[8 * j + e] = a0[e]; v[8 * j + 4 + e] = a1[e]; ss += a0[e] * a0[e] + a1[e] * a1[e]; } }
        const float rstd = rsqrtf(wave_sum(ss) * (1.0f / DM) + EPS);
#pragma unroll
        for (int j = 0; j < 4; ++j) {
            u32x4 w; w.x = cvt_pk_b16(v[8 * j + 0] * rstd, v[8 * j + 1] * rstd); w.y = cvt_pk_b16(v[8 * j + 2] * rstd, v[8 * j + 3] * rstd);
            w.z = cvt_pk_b16(v[8 * j + 4] * rstd, v[8 * j + 5] * rstd); w.w = cvt_pk_b16(v[8 * j + 6] * rstd, v[8 * j + 7] * rstd);
            *(u32x4*)(xn + (size_t)m * DM + 512 * j + 8 * lane) = w; }
        if (lane == 0) rstd_out[m] = rstd;
    }
}
__device__ __forceinline__ void resnorm_rows(const bf16_t* f, bf16_t* xn, float* rstd, float* hout32, float coef, const float* g_post, int gw, int NGW, int lane, unsigned char* xn8 = nullptr) {
    float gp[32];
#pragma unroll
    for (int j = 0; j < 4; ++j) { const f32x4 a0 = *(const f32x4*)(g_post + 512 * j + 8 * lane), a1 = *(const f32x4*)(g_post + 512 * j + 8 * lane + 4);
#pragma unroll
        for (int e = 0; e < 4; ++e) { gp[8 * j + e] = a0[e] * coef; gp[8 * j + 4 + e] = a1[e] * coef; } }
    u32x4 fw[4], hw[4]; float rprev = 1.0f;
#pragma unroll
    for (int j = 0; j < 4; ++j) { fw[j] = (u32x4){0u, 0u, 0u, 0u}; hw[j] = (u32x4){0u, 0u, 0u, 0u}; }
    auto issue = [&](int m) {
#pragma unroll
        for (int j = 0; j < 4; ++j) { const size_t off = (size_t)m * DM + 512 * j + 8 * lane; fw[j] = *(const u32x4*)(f + off); hw[j] = *(const u32x4*)(xn + off); }
        rprev = rstd[m]; };
    if (gw < M) issue(gw);
    for (int m = gw; m < M; m += NGW) {
        float fv[32], hv[32]; float ss = 0.f; const float hs = 1.0f / rprev;
#pragma unroll
        for (int j = 0; j < 4; ++j) { const u32x4 w = fw[j];
            fv[8 * j + 0] = bflo(w.x); fv[8 * j + 1] = bfhi(w.x); fv[8 * j + 2] = bflo(w.y); fv[8 * j + 3] = bfhi(w.y); fv[8 * j + 4] = bflo(w.z); fv[8 * j + 5] = bfhi(w.z); fv[8 * j + 6] = bflo(w.w); fv[8 * j + 7] = bfhi(w.w);
            const u32x4 h4 = hw[j];
            hv[8 * j + 0] = b16lo(h4.x) * hs; hv[8 * j + 1] = b16hi(h4.x) * hs; hv[8 * j + 2] = b16lo(h4.y) * hs; hv[8 * j + 3] = b16hi(h4.y) * hs; hv[8 * j + 4] = b16lo(h4.z) * hs; hv[8 * j + 5] = b16hi(h4.z) * hs; hv[8 * j + 6] = b16lo(h4.w) * hs; hv[8 * j + 7] = b16hi(h4.w) * hs;
#pragma unroll
            for (int e = 0; e < 8; ++e) ss += fv[8 * j + e] * fv[8 * j + e]; }
        if (m + NGW < M) issue(m + NGW);
        const float rs = rsqrtf(wave_sum(ss) * (1.0f / DM) + EPS);
        float ss2 = 0.f;
#pragma unroll
        for (int j = 0; j < 4; ++j) {
#pragma unroll
            for (int e = 0; e < 8; ++e) { const float o = hv[8 * j + e] + fv[8 * j + e] * rs * gp[8 * j + e]; ss2 += o * o; fv[8 * j + e] = o; }
            if (hout32) { const size_t off = (size_t)m * DM + 512 * j + 8 * lane;
                *(f32x4*)(hout32 + off) = (f32x4){fv[8 * j + 0], fv[8 * j + 1], fv[8 * j + 2], fv[8 * j + 3]}; *(f32x4*)(hout32 + off + 4) = (f32x4){fv[8 * j + 4], fv[8 * j + 5], fv[8 * j + 6], fv[8 * j + 7]}; } }
        if (!hout32) {
            const float rn = rsqrtf(wave_sum(ss2) * (1.0f / DM) + EPS);
#pragma unroll
            for (int j = 0; j < 4; ++j) {
                u32x4 w; w.x = cvt_pk_b16(fv[8 * j + 0] * rn, fv[8 * j + 1] * rn); w.y = cvt_pk_b16(fv[8 * j + 2] * rn, fv[8 * j + 3] * rn);
                w.z = cvt_pk_b16(fv[8 * j + 4] * rn, fv[8 * j + 5] * rn); w.w = cvt_pk_b16(fv[8 * j + 6] * rn, fv[8 * j + 7] * rn);
                *(u32x4*)(xn + (size_t)m * DM + 512 * j + 8 * lane) = w;
                if (xn8) { u32x2 b; b.x = pk_fp8x4(fv[8 * j + 0] * rn, fv[8 * j + 1] * rn, fv[8 * j + 2] * rn, fv[8 * j + 3] * rn); b.y = pk_fp8x4(fv[8 * j + 4] * rn, fv[8 * j + 5] * rn, fv[8 * j + 6] * rn, fv[8 * j + 7] * rn);
                    *(u32x2*)(xn8 + (size_t)m * DM + 512 * j + 8 * lane) = b; } }
            if (lane == 0) rstd[m] = rn;
        }
    }
}

__device__ __forceinline__ int rel_bucket(int dist) {
    if (dist < 16) return dist;
    const float d = (float)dist;
    int large = 16 + (int)(logf(d / 16.0f) / 4.852030263919617f * 16.0f);
    return large < 31 ? large : 31;
}

struct WinArgs {
    const bf16_t* q; const bf16_t* k; const bf16_t* v;
    long rstride;
    int first;
    int maxdist;
    const float* biascol; int dil;
    float sink; int has_sink;
    bf16_t* out; long ostride;
    float* lse; long lstride;
};
constexpr int AW_KS = 0, AW_VT = 36864, AW_PS = 36864 + 36864, AW_BT = AW_PS + 8 * 5376;
struct WinRegs { u32x4 k[4], v[4]; bf16x8 q0, q1; float bias; };
__device__ __forceinline__ void win_fetch(const WinArgs& A, int tid, int wave, int lane, WinRegs& R) {
#pragma unroll
    for (int i = 0; i < 4; ++i) {
        const int cidx = tid + 512 * i, j = cidx >> 3, part = cidx & 7;
        R.k[i] = (u32x4){0u, 0u, 0u, 0u}; R.v[i] = (u32x4){0u, 0u, 0u, 0u};
        if (!(A.first && j < 128)) { R.k[i] = *(const u32x4*)(A.k + (long)j * A.rstride + part * 8); R.v[i] = *(const u32x4*)(A.v + (long)j * A.rstride + part * 8); }
    }
    const bf16_t* qrow = A.q + (long)(16 * wave + (lane & 15)) * A.rstride;
    R.q0 = *(const bf16x8*)(qrow + 8 * (lane >> 4)); R.q1 = *(const bf16x8*)(qrow + 32 + 8 * (lane >> 4));
    R.bias = -3.0e38f;
    if (tid < 384) { const int dd = tid - 128; if (dd >= 0 && dd <= A.maxdist) R.bias = A.biascol[rel_bucket(dd * A.dil) * 20]; }
}
__device__ __forceinline__ void attn_win_item(LAS unsigned char* lds, const WinArgs& A, WinRegs& R, bool hasnext, const WinArgs& An, int tid, int wave, int lane) {
    LAS bf16_t* KS = (LAS bf16_t*)(lds + AW_KS);
    LAS bf16_t* VT = (LAS bf16_t*)(lds + AW_VT);
    LAS bf16_t* PS = (LAS bf16_t*)(lds + AW_PS) + wave * (16 * 168);
    LAS float* BT = (LAS float*)(lds + AW_BT);
    __syncthreads();
#pragma unroll
    for (int i = 0; i < 4; ++i) {
        const int cidx = tid + 512 * i, j = cidx >> 3, part = cidx & 7;
        *(LAS u32x4*)(KS + j * 72 + part * 8) = R.k[i];
        *(LAS u32x4*)(VT + j * 72 + part * 8) = R.v[i];
    }
    if (tid < 384) BT[tid] = R.bias;
    const bf16x8 qa0 = R.q0, qa1 = R.q1;
    __syncthreads();
    if (hasnext) win_fetch(An, tid, wave, lane, R);
    const int c = lane & 15, g = lane >> 4, st = wave < 6 ? wave : 6;
    f32x4 s[10];
#pragma unroll
    for (int jt = 0; jt < 10; ++jt) {
        const LAS bf16_t* kr = KS + (16 * (st + jt) + c) * 72 + 8 * g;
        const bf16x8 kb0 = *(const LAS bf16x8*)kr, kb1 = *(const LAS bf16x8*)(kr + 32);
        f32x4 z = (f32x4){0.f, 0.f, 0.f, 0.f};
        z = MFMA16(qa0, kb0, z);
        z = MFMA16(qa1, kb1, z);
        s[jt] = z;
    }
    float mx[4] = {-3.0e38f, -3.0e38f, -3.0e38f, -3.0e38f};
    { const LAS float* bp = BT + (16 * wave + 4 * g - 16 * st - c + 256 - 144);
#pragma unroll
      for (int jt = 0; jt < 10; ++jt) {
#pragma unroll
          for (int i = 0; i < 4; ++i) { const float lg = s[jt][i] * 0.125f + bp[144 + i - 16 * jt]; s[jt][i] = lg; mx[i] = fmaxf(mx[i], lg); } }
      if (A.first) {
#pragma unroll
          for (int jt = 0; jt < 10; ++jt) { if (16 * (st + jt) + c < 128) {
#pragma unroll
              for (int i = 0; i < 4; ++i) s[jt][i] = -3.0e38f; } }
#pragma unroll
          for (int i = 0; i < 4; ++i) { mx[i] = -3.0e38f;
#pragma unroll
              for (int jt = 0; jt < 10; ++jt) mx[i] = fmaxf(mx[i], s[jt][i]); } } }
#pragma unroll
    for (int i = 0; i < 4; ++i) {
        mx[i] = row16_max(mx[i]);
        if (A.has_sink) mx[i] = fmaxf(mx[i], A.sink);
    }
    float sm[4] = {0.f, 0.f, 0.f, 0.f};
#pragma unroll
    for (int jt = 0; jt < 10; ++jt) {
#pragma unroll
        for (int i = 0; i < 4; ++i) {
            const float p = __expf(s[jt][i] - mx[i]);
            sm[i] += p;
            PS[(4 * g + i) * 168 + 16 * jt + c] = f2bf(p);
        }
    }
#pragma unroll
    for (int i = 0; i < 4; ++i) {
        sm[i] = row16_sum(sm[i]);
        if (A.has_sink) sm[i] += __expf(A.sink - mx[i]);
    }
    LDS_WAIT();
    f32x4 o[4];
#pragma unroll
    for (int dt = 0; dt < 4; ++dt) o[dt] = (f32x4){0.f, 0.f, 0.f, 0.f};
    const unsigned vaddr = lds_addr(VT + (16 * st + 8 * g + (c >> 2)) * 72 + 4 * (c & 3));
#pragma unroll
    for (int ks = 0; ks < 5; ++ks) {
        const bf16x8 pa = *(const LAS bf16x8*)(PS + c * 168 + 32 * ks + 8 * g);
        bf16x8 vb[4]; tr_frag4<576>(vaddr + ks * (32 * 144), vb);
#pragma unroll
        for (int dt = 0; dt < 4; ++dt) o[dt] = MFMA16(pa, vb[dt], o[dt]);
    }
#pragma unroll
    for (int i = 0; i < 4; ++i) {
        const float inv = 1.0f / sm[i];
        bf16_t* orow = A.out + (long)(16 * wave + 4 * g + i) * A.ostride;
#pragma unroll
        for (int dt = 0; dt < 4; ++dt) orow[16 * dt + c] = A.has_sink ? f2b16(o[dt][i] * inv) : f2bf(o[dt][i] * inv);
        if (A.lse && c == 0) A.lse[(long)(16 * wave + 4 * g + i) * A.lstride] = mx[i] + __logf(sm[i]);
    }
}

constexpr float SB_THR = -30.0f;
constexpr int SB_KS = 0, SB_VT = 18432, SB_PS = 18432 + 18432;
__device__ __forceinline__ void stickbreak_item(LAS unsigned char* lds, volatile LAS unsigned* flag, const bf16_t* proj, bf16_t* yall, int b, int h, int nb, int tid, int wave, int lane) {
    LAS bf16_t* KS = (LAS bf16_t*)(lds + SB_KS);
    LAS bf16_t* VT = (LAS bf16_t*)(lds + SB_VT);
    LAS bf16_t* PS = (LAS bf16_t*)(lds + SB_PS) + wave * (16 * 136);
    const int c = lane & 15, g = lane >> 4;
    const long tok0 = (long)b * SEQ + 128 * nb;
    const bf16_t* qrow = proj + (tok0 + 16 * wave + c) * MIXIN + BQ + h * 64;
    const bf16x8 qa0 = *(const bf16x8*)(qrow + 8 * g), qa1 = *(const bf16x8*)(qrow + 32 + 8 * g);
    float R[4] = {0.f, 0.f, 0.f, 0.f};
    f32x4 o[4];
#pragma unroll
    for (int dt = 0; dt < 4; ++dt) o[dt] = (f32x4){0.f, 0.f, 0.f, 0.f};
    bool wdone = false;
    if (tid == 0) flag[0] = 0u;
    for (int kb = nb; kb >= 0; --kb) {
        __syncthreads();
        const bf16_t* kbase = proj + ((long)b * SEQ + 128 * kb) * MIXIN + h * 64;
#pragma unroll
        for (int i = 0; i < 2; ++i) {
            const int cidx = tid + 512 * i, j = cidx >> 3, part = cidx & 7;
            const u32x4 kw = *(const u32x4*)(kbase + (long)j * MIXIN + BKo + part * 8), vw = *(const u32x4*)(kbase + (long)j * MIXIN + BVo + part * 8);
            *(LAS u32x4*)(KS + j * 72 + part * 8) = kw;
            *(LAS u32x4*)(VT + j * 72 + part * 8) = vw;
        }
        __syncthreads();
        if (!wdone) {
            const bool diag = (kb == nb);
            const int jt_hi = diag ? wave : 7;
            if (diag) { for (int jt = wave + 1; jt < 8; ++jt) {
#pragma unroll
                    for (int i = 0; i < 4; ++i) PS[(4 * g + i) * 136 + 16 * jt + c] = 0; } }
            for (int jt = jt_hi; jt >= 0; --jt) {
                const LAS bf16_t* kr = KS + (16 * jt + c) * 72 + 8 * g;
                const bf16x8 kb0 = *(const LAS bf16x8*)kr, kb1 = *(const LAS bf16x8*)(kr + 32);
                f32x4 z = (f32x4){0.f, 0.f, 0.f, 0.f};
                z = MFMA16(qa0, kb0, z);
                z = MFMA16(qa1, kb1, z);
#pragma unroll
                for (int i = 0; i < 4; ++i) {
                    const float zz = z[i] * 0.125f;
                    const bool past = !diag || jt < wave || c < 4 * g + i;
                    const float sp = fmaxf(zz, 0.f) + __logf(1.0f + __expf(-fabsf(zz)));
                    const float lk = past ? -sp : 0.f;
                    float inc = lk;
                    inc += dpp_f<0x101>(inc); inc += dpp_f<0x102>(inc); inc += dpp_f<0x104>(inc); inc += dpp_f<0x108>(inc);
                    const float between = R[i] + inc - lk;
                    const float a = past ? __expf(zz - sp + between) : 0.f;
                    R[i] += __shfl(inc, 0, 16);
                    PS[(4 * g + i) * 136 + 16 * jt + c] = f2bf(a);
                }
                if (jt > 0 && __all(fmaxf(fmaxf(R[0], R[1]), fmaxf(R[2], R[3])) < SB_THR)) {
                    for (int j2 = jt - 1; j2 >= 0; --j2) {
#pragma unroll
                        for (int i = 0; i < 4; ++i) PS[(4 * g + i) * 136 + 16 * j2 + c] = 0; }
                    break; }
            }
            LDS_WAIT();
#pragma unroll
            for (int ks = 0; ks < 4; ++ks) {
                const bf16x8 pa = *(const LAS bf16x8*)(PS + c * 136 + 32 * ks + 8 * g);
                bf16x8 vb[4]; tr_frag4<576>(lds_addr(VT + (8 * g + (c >> 2)) * 72 + 4 * (c & 3)) + ks * (32 * 144), vb);
#pragma unroll
                for (int dt = 0; dt < 4; ++dt) o[dt] = MFMA16(pa, vb[dt], o[dt]);
            }
            const float rmax = fmaxf(fmaxf(R[0], R[1]), fmaxf(R[2], R[3]));
            wdone = __all(rmax < SB_THR);
        }
        if (!wdone && lane == 0) flag[0] = (unsigned)(kb + 1);
        __syncthreads();
        if (flag[0] != (unsigned)(kb + 1)) break;
    }
#pragma unroll
    for (int i = 0; i < 4; ++i) {
        bf16_t* orow = yall + (tok0 + 16 * wave + 4 * g + i) * BRT + 512 + h * 64;
#pragma unroll
        for (int dt = 0; dt < 4; ++dt) orow[16 * dt + c] = f2b16(o[dt][i]);
    }
}

constexpr int H1_GT = 0, H1_BR = 2048, H1_BL = 2560, H1_QS = 3072, H1_KS = H1_QS + 33792, H1_KDT = H1_KS + 33792, H1_VT = H1_KDT + 18432, H1_PS = H1_VT + 18432;
__device__ __forceinline__ void hgrn_a1_load(const Args& a, int item, int tid, unsigned (&fq)[16], unsigned (&vp)[8]) {
    const bf16_t* proj = (const bf16_t*)(a.ws + WS_PROJ);
    const int cch = item & 63, h = (item >> 6) & 3, b = item >> 8, k = tid & 127, rg = tid >> 7;
    const bf16_t* p = proj + ((long)b * SEQ + 64 * cch + 16 * rg) * MIXIN + h * 128 + k;
#pragma unroll
    for (int r = 0; r < 16; ++r) { const unsigned f = p[(long)r * MIXIN + AF], q = p[(long)r * MIXIN + AQ], v = p[(long)r * MIXIN + AI]; fq[r] = f | (q << 16); if (r & 1) vp[r >> 1] |= v << 16; else vp[r >> 1] = v; }
}
__device__ __forceinline__ void hgrn_a1_item(LAS unsigned char* lds, const Args& a, int l, int item, int next_item, unsigned (&fq)[16], unsigned (&vp)[8], int tid, int wave, int lane) {
    const int cch = item & 63, h = (item >> 6) & 3, b = item >> 8;
    const long tok0 = (long)b * SEQ + 64 * cch;
    LAS float* GT = (LAS float*)(lds + H1_GT);
    LAS float* BR = (LAS float*)(lds + H1_BR);
    LAS float* BL = (LAS float*)(lds + H1_BL);
    LAS float* QS = (LAS float*)(lds + H1_QS);
    LAS float* KS = (LAS float*)(lds + H1_KS);
    LAS bf16_t* KDT = (LAS bf16_t*)(lds + H1_KDT);
    LAS bf16_t* VT = (LAS bf16_t*)(lds + H1_VT);
    LAS bf16_t* PS = (LAS bf16_t*)(lds + H1_PS);
    const int k = tid & 127, rg = tid >> 7;
    float lb;
    { const float* lg = a.lb_logits + h * 128 + k; const float l0 = lg[0], l1 = lg[512], l2 = lg[1024], l3 = lg[1536];
      const float mxl = fmaxf(fmaxf(l0, l1), fmaxf(l2, l3)); const float e0 = __expf(l0 - mxl), e1 = __expf(l1 - mxl), e2 = __expf(l2 - mxl), e3 = __expf(l3 - mxl);
      const float inv = 1.0f / (e0 + e1 + e2 + e3);
      lb = (l >= 1 ? e1 : 0.f) + (l >= 2 ? e2 : 0.f) + (l >= 3 ? e3 : 0.f); lb *= inv; }
    __syncthreads();
    float kk[16], bb[16];
    { float run = 0.f;
#pragma unroll
      for (int r = 0; r < 16; ++r) { const float fl = bf2f((bf16_t)(fq[r] & 0xffffu));
          const float f = lb + (1.0f - lb) * fast_sigmoid(fl); kk[r] = 1.0f - f; run += __logf(f); bb[r] = run; }
      GT[rg * 128 + k] = run; }
    __syncthreads();
    { float pre = 0.f;
#pragma unroll
      for (int r2 = 0; r2 < 3; ++r2) pre += (r2 < rg) ? GT[r2 * 128 + k] : 0.f;
#pragma unroll
      for (int r = 0; r < 16; ++r) bb[r] += pre;
      if (rg == 1) BR[k] = bb[15];
      if (rg == 3) BL[k] = bb[15]; }
    __syncthreads();
    { const float bref = BR[k], blast = BL[k];
      bf16_t* qi_out = (bf16_t*)(a.ws + WS_QI) + ((size_t)item * 64 + 16 * rg) * 128 + k;
      unsigned kd[8];
#pragma unroll
      for (int r = 0; r < 16; ++r) {
          const float q = bf2f((bf16_t)(fq[r] >> 16));
          const float qs = q * __expf(bb[r] - bref), ks = kk[r] * __expf(bref - bb[r]), kdv = kk[r] * __expf(blast - bb[r]), qi = q * __expf(bb[r]);
          QS[(16 * rg + r) * 132 + k] = qs; KS[(16 * rg + r) * 132 + k] = ks;
          qi_out[(size_t)r * 128] = f2bf(qi);
          const unsigned kdb = f2bf(kdv);
          if (r & 1) kd[r >> 1] |= kdb << 16; else kd[r >> 1] = kdb;
      }
      *(LAS u32x4*)(KDT + k * 72 + 16 * rg) = (u32x4){kd[0], kd[1], kd[2], kd[3]}; *(LAS u32x4*)(KDT + k * 72 + 16 * rg + 8) = (u32x4){kd[4], kd[5], kd[6], kd[7]};
      *(LAS u32x4*)(VT + k * 72 + 16 * rg) = (u32x4){vp[0], vp[1], vp[2], vp[3]}; *(LAS u32x4*)(VT + k * 72 + 16 * rg + 8) = (u32x4){vp[4], vp[5], vp[6], vp[7]};
      if (rg == 3) ((float*)(a.ws + WS_DC))[(size_t)item * 128 + k] = __expf(blast); }
    if (next_item >= 0) hgrn_a1_load(a, next_item, tid, fq, vp);
    __syncthreads();
    const int c = lane & 15, g = lane >> 4;
    { const int mt = wave >> 1;
#pragma unroll
      for (int e = 0; e < 2; ++e) { const int nt = 2 * (wave & 1) + e;
          f32x4 z = (f32x4){0.f, 0.f, 0.f, 0.f};
          if (nt <= mt) {
#pragma unroll
              for (int Mi = 0; Mi < 8; ++Mi) { const f32x4 a4 = *(const LAS f32x4*)(QS + (16 * mt + c) * 132 + 16 * Mi + 4 * g), b4 = *(const LAS f32x4*)(KS + (16 * nt + c) * 132 + 16 * Mi + 4 * g);
#pragma unroll
                  for (int j = 0; j < 4; ++j) z = __builtin_amdgcn_mfma_f32_16x16x4f32(a4[j], b4[j], z, 0, 0, 0); } }
#pragma unroll
          for (int i = 0; i < 4; ++i) { const int t = 16 * mt + 4 * g + i, s = 16 * nt + c; PS[t * 72 + s] = (s <= t) ? f2bf(z[i]) : (bf16_t)0; } } }
    __syncthreads();
    { const int mt = wave >> 1;
      bf16_t* oi = (bf16_t*)(a.ws + WS_OINTRA) + (size_t)item * 64 * 128;
      bf16x8 pa[2];
#pragma unroll
      for (int ks = 0; ks < 2; ++ks) pa[ks] = *(const LAS bf16x8*)(PS + (16 * mt + c) * 72 + 32 * ks + 8 * g);
#pragma unroll
      for (int e = 0; e < 4; ++e) { const int vt = 4 * (wave & 1) + e; f32x4 z = (f32x4){0.f, 0.f, 0.f, 0.f};
#pragma unroll
          for (int ks = 0; ks < 2; ++ks) { const bf16x8 vb = *(const LAS bf16x8*)(VT + (16 * vt + c) * 72 + 32 * ks + 8 * g); z = MFMA16(vb, pa[ks], z); }
          u32x2 w; w.x = cvt_pk_bf16(z[0], z[1]); w.y = cvt_pk_bf16(z[2], z[3]); *(u32x2*)(oi + (size_t)(16 * mt + c) * 128 + 16 * vt + 4 * g) = w; }
      bf16_t* U = (bf16_t*)(a.ws + WS_U) + (size_t)item * 128 * 128;
      bf16x8 ka[2];
#pragma unroll
      for (int ks = 0; ks < 2; ++ks) ka[ks] = *(const LAS bf16x8*)(KDT + (16 * wave + c) * 72 + 32 * ks + 8 * g);
#pragma unroll
      for (int vt = 0; vt < 8; ++vt) { f32x4 z = (f32x4){0.f, 0.f, 0.f, 0.f};
#pragma unroll
          for (int ks = 0; ks < 2; ++ks) { const bf16x8 vb = *(const LAS bf16x8*)(VT + (16 * vt + c) * 72 + 32 * ks + 8 * g); z = MFMA16(vb, ka[ks], z); }
          u32x2 w; w.x = cvt_pk_bf16(z[0], z[1]); w.y = cvt_pk_bf16(z[2], z[3]); *(u32x2*)(U + (size_t)(16 * wave + c) * 128 + 16 * vt + 4 * g) = w; } }
}
__device__ __forceinline__ void hgrn_a2(const Args& a, int gtid, int gthreads) {
    const bf16_t* U = (const bf16_t*)(a.ws + WS_U); const float* DC = (const float*)(a.ws + WS_DC); bf16_t* SP = (bf16_t*)(a.ws + WS_SPREV);
    for (int e = gtid; e < 32 * 128 * 32; e += gthreads) {
        const int v4 = e & 31, k = (e >> 5) & 127, bh = e >> 12;
        f32x4 S = (f32x4){0.f, 0.f, 0.f, 0.f};
        u32x2 ub[8]; float db[8];
#pragma unroll
        for (int j = 0; j < 8; ++j) { const size_t it = (size_t)bh * 64 + j; ub[j] = *(const u32x2*)(U + (it * 128 + k) * 128 + 4 * v4); db[j] = DC[it * 128 + k]; }
        for (int c0 = 0; c0 < 64; c0 += 8) {
#pragma unroll
            for (int j = 0; j < 8; ++j) {
                const size_t it = (size_t)bh * 64 + c0 + j;
                const u32x2 uw = ub[j]; const float d = db[j];
                if (c0 + 8 < 64) { const size_t itn = it + 8; ub[j] = *(const u32x2*)(U + (itn * 128 + k) * 128 + 4 * v4); db[j] = DC[itn * 128 + k]; }
                const f32x4 u = (f32x4){bflo(uw.x), bfhi(uw.x), bflo(uw.y), bfhi(uw.y)};
                u32x2 w; w.x = cvt_pk_bf16(S[0], S[1]); w.y = cvt_pk_bf16(S[2], S[3]);
                *(u32x2*)(SP + (it * 128 + k) * 128 + 4 * v4) = w;
                S = S * d + u;
            }
        }
    }
}
constexpr int H3_ST = 0, H3_SS = 36864;
__device__ __forceinline__ void hgrn_a3_item(LAS unsigned char* lds, const Args& a, int l, int item, int tid, int wave, int lane) {
    const bf16_t* proj = (const bf16_t*)(a.ws + WS_PROJ); bf16_t* yall = (bf16_t*)(a.ws + WS_YALL);
    const int cch = item & 63, h = (item >> 6) & 3, b = item >> 8;
    const long tok0 = (long)b * SEQ + 64 * cch;
    LAS bf16_t* ST = (LAS bf16_t*)(lds + H3_ST); LAS float* SS = (LAS float*)(lds + H3_SS);
    const bf16_t* SP = (const bf16_t*)(a.ws + WS_SPREV) + (size_t)item * 128 * 128;
    __syncthreads();
#pragma unroll
    for (int i = 0; i < 4; ++i) { const int cidx = tid + 512 * i, kr = cidx >> 4, part = cidx & 15;
        const u32x4 w = *(const u32x4*)(SP + (size_t)kr * 128 + 8 * part);
        *(LAS u32x4*)(ST + kr * 144 + 8 * part) = w; }
    __syncthreads();
    const int c = lane & 15, g = lane >> 4, mt = wave >> 1;
    const bf16_t* qi = (const bf16_t*)(a.ws + WS_QI) + ((size_t)item * 64 + 16 * mt + c) * 128;
    const bf16_t* oi = (const bf16_t*)(a.ws + WS_OINTRA) + (size_t)item * 64 * 128;
    bf16x8 qa[4];
#pragma unroll
    for (int ks = 0; ks < 4; ++ks) qa[ks] = *(const bf16x8*)(qi + 32 * ks + 8 * g);
    f32x4 o[4];
#pragma unroll
    for (int e = 0; e < 4; ++e) o[e] = (f32x4){0.f, 0.f, 0.f, 0.f};
    { const unsigned saddr = lds_addr(ST + (8 * g + (c >> 2)) * 144 + 64 * (wave & 1) + 4 * (c & 3));
#pragma unroll
      for (int ks = 0; ks < 4; ++ks) { bf16x8 sb[4]; tr_frag4<1152>(saddr + ks * (32 * 288), sb);
#pragma unroll
          for (int e = 0; e < 4; ++e) o[e] = MFMA16(sb[e], qa[ks], o[e]); } }
    const int t = 16 * mt + c; float ss = 0.f;
#pragma unroll
    for (int e = 0; e < 4; ++e) { const int v0 = 16 * (4 * (wave & 1) + e) + 4 * g; const u32x2 w = *(const u32x2*)(oi + (size_t)t * 128 + v0);
        f32x4 z = o[e]; z[0] += bflo(w.x); z[1] += bfhi(w.x); z[2] += bflo(w.y); z[3] += bfhi(w.y);
        ss += (z[0] * z[0] + z[1] * z[1]) + (z[2] * z[2] + z[3] * z[3]); o[e] = z; }
    ss += __shfl_xor(ss, 16); ss += __shfl_xor(ss, 32);
    if (g == 0) SS[t * 2 + (wave & 1)] = ss;
    __syncthreads();
    { const float rstd = rsqrtf((SS[t * 2] + SS[t * 2 + 1]) * (1.0f / 128.0f) + EPS);
      const long tok = tok0 + t;
#pragma unroll
      for (int e = 0; e < 4; ++e) { const int v0 = 16 * (4 * (wave & 1) + e) + 4 * g;
          const u32x2 gw = *(const u32x2*)(proj + tok * MIXIN + AG + h * 128 + v0); const f32x4 ng = *(const f32x4*)(a.hgrn_norm + l * 128 + v0);
          const float gt[4] = {bflo(gw.x), bfhi(gw.x), bflo(gw.y), bfhi(gw.y)}; float y[4];
#pragma unroll
          for (int i = 0; i < 4; ++i) y[i] = o[e][i] * rstd * ng[i] * (gt[i] * fast_sigmoid(gt[i]));
          u32x2 w; w.x = cvt_pk_b16(y[0], y[1]); w.y = cvt_pk_b16(y[2], y[3]); *(u32x2*)(yall + tok * BRT + h * 128 + v0) = w; } }
}
__device__ __forceinline__ void c_combine(const Args& a, int gtid, int gthreads) {
    const bf16_t* CP = (const bf16_t*)(a.ws + WS_CPART); const float* LS = (const float*)(a.ws + WS_CLSE); bf16_t* yall = (bf16_t*)(a.ws + WS_YALL);
    for (int e = gtid; e < M * 32; e += gthreads) {
        const int part = e & 31, tok = e >> 5, h4 = part >> 3;
        const float l0 = LS[(size_t)tok * 4 + h4], l1 = LS[((size_t)M + tok) * 4 + h4], l2 = LS[((size_t)2 * M + tok) * 4 + h4];
        const float mx = fmaxf(l0, fmaxf(l1, l2)); float w0 = __expf(l0 - mx), w1 = __expf(l1 - mx), w2 = __expf(l2 - mx); const float inv = 1.0f / (w0 + w1 + w2); w0 *= inv; w1 *= inv; w2 *= inv;
        const u32x4 p0 = *(const u32x4*)(CP + (size_t)tok * 256 + 8 * part), p1 = *(const u32x4*)(CP + ((size_t)M + tok) * 256 + 8 * part), p2 = *(const u32x4*)(CP + ((size_t)2 * M + tok) * 256 + 8 * part);
        u32x4 o;
        o.x = cvt_pk_b16(w0 * bflo(p0.x) + w1 * bflo(p1.x) + w2 * bflo(p2.x), w0 * bfhi(p0.x) + w1 * bfhi(p1.x) + w2 * bfhi(p2.x));
        o.y = cvt_pk_b16(w0 * bflo(p0.y) + w1 * bflo(p1.y) + w2 * bflo(p2.y), w0 * bfhi(p0.y) + w1 * bfhi(p1.y) + w2 * bfhi(p2.y));
        o.z = cvt_pk_b16(w0 * bflo(p0.z) + w1 * bflo(p1.z) + w2 * bflo(p2.z), w0 * bfhi(p0.z) + w1 * bfhi(p1.z) + w2 * bfhi(p2.z));
        o.w = cvt_pk_b16(w0 * bflo(p0.w) + w1 * bflo(p1.w) + w2 * bflo(p2.w), w0 * bfhi(p0.w) + w1 * bfhi(p1.w) + w2 * bfhi(p2.w));
        *(u32x4*)(yall + (size_t)tok * BRT + 1024 + 8 * part) = o;
    }
}

__device__ __forceinline__ WinArgs win_args_c(const Args& a, const bf16_t* proj, int it) {
    const int sub = it & 31, h4 = (it >> 5) & 3, bg = it >> 7, g = bg % 3, b = bg / 3;
    const int r = g == 0 ? 1 : (g == 1 ? 4 : 16); const int nper = 32 / r, res = sub / nper, n = sub % nper;
    const long tq = (long)b * SEQ + (long)(128 * n) * r + res, tk = tq - (long)128 * r;
    WinArgs W; W.q = proj + tq * MIXIN + CQ + g * 256 + h4 * 64; W.k = proj + tk * MIXIN + CKo + g * 256 + h4 * 64; W.v = proj + tk * MIXIN + CVo + g * 256 + h4 * 64;
    W.rstride = (long)r * MIXIN; W.first = (n == 0); W.maxdist = 128; W.biascol = a.rel_bias + g * 4 + h4; W.dil = r; W.sink = 0.f; W.has_sink = 0;
    W.out = (bf16_t*)(a.ws + WS_CPART) + ((size_t)g * M + tq) * 256 + h4 * 64; W.ostride = (long)r * 256;
    W.lse = (float*)(a.ws + WS_CLSE) + ((size_t)g * M + tq) * 4 + h4; W.lstride = (long)r * 4;
    return W;
}
__device__ __forceinline__ WinArgs win_args_d(const Args& a, const bf16_t* proj, bf16_t* yall, int l, int it) {
    const int nb = it & 31, hq = (it >> 5) & 7, b = it >> 8, kvh = hq >> 2;
    const long tq = (long)b * SEQ + 128 * nb, tk = tq - 128;
    WinArgs W; W.q = proj + tq * MIXIN + DQo + hq * 64; W.k = proj + tk * MIXIN + DKo + kvh * 64; W.v = proj + tk * MIXIN + DVo + kvh * 64;
    W.rstride = MIXIN; W.first = (nb == 0); W.maxdist = 127; W.biascol = a.rel_bias + 12 + hq; W.dil = 1; W.sink = a.sinks[l * 8 + hq]; W.has_sink = 1;
    W.out = yall + tq * BRT + 1280 + hq * 64; W.ostride = BRT; W.lse = nullptr; W.lstride = 0;
    return W;
}

constexpr int LDS_BYTES = 147456;
constexpr int LDS_MISC = 131072;
constexpr int NPH = 14;

__global__ void __launch_bounds__(512, 2) fwd_kernel(Args a) {
    extern __shared__ __attribute__((aligned(16))) unsigned char lds_raw[];
    LAS unsigned char* lds = (LAS unsigned char*)lds_raw;
    const int G = gridDim.x, bid = blockIdx.x;
    const int NGW = G * 8, gthreads = G * 512;
#define LAUNDER() int tid_ = threadIdx.x; asm volatile("" : "+v"(tid_)); const int tid = tid_, lane = tid & 63, wave = __builtin_amdgcn_readfirstlane(tid >> 6), gw = bid * 8 + wave, gtid = bid * 512 + tid; (void)lane; (void)gw; (void)gtid
    unsigned char* ws = a.ws;
    volatile LAS unsigned* MISC = (volatile LAS unsigned*)(lds + LDS_MISC);
    if (threadIdx.x < 64) MISC[threadIdx.x] = 0u;
    __syncthreads();
#if MK_ONE_LAUNCH
    XcdBarrier bar = xcd_barrier_post((unsigned*)(ws + WS_CTL) + CW_BAR, MISC + 8);
#define GRID_BAR() xcd_barrier(bar)
#else
#define GRID_BAR() do { } while (0)
#endif
    bf16_t* XN = (bf16_t*)(ws + WS_H16);
    float* RSTD = (float*)(ws + WS_CTL + 512 * 1024);
    for (int l = a.l_lo; l < a.l_hi; ++l) {
        const int lo = a.ph_lo, hi = a.ph_hi;
#define IN(k) (((PHMASK >> (k)) & 1) && lo <= (k) && (k) < hi)
        if (IN(0) && l == 0) {
            LAUNDER();
            convert_weights(a, 0, lds, bid, G, lane, wave);
            prenorm_rows(a.x, XN, RSTD, gw, NGW, lane);
            GRID_BAR();
        }
        if (IN(1)) for (int rep_ = 0; rep_ < (((RPT_MASK >> 1) & 1) ? 2 : 1); ++rep_) {
            LAUNDER();
            pg8::SchedPlain S; S.o.init(M / 256, 2 * DFF / 256, G, bid, COLCH); S.A = (const char*)XN; S.B = (const char*)(ws + WS_W13A); S.tstepA = (size_t)256 * DM * 2; S.tstepB = (size_t)256 * DM * 2; S.nt = DM / 64;
            pg8::EpiSwiglu E{(bf16_t*)(ws + WS_ACT), DFF};
            pg8::gemm_phase<false, GSP2, GALIGN>(lds, DM, DM, S, E);
            GRID_BAR();
        }
        if (IN(2)) for (int rep_ = 0; rep_ < (((RPT_MASK >> 2) & 1) ? 2 : 1); ++rep_) {
            LAUNDER();
            pg8::SchedPlain S; S.o.init(M / 256, DM / 256, G, bid, 1); S.A = (const char*)(ws + WS_ACT); S.B = (const char*)(ws + WS_W2A); S.tstepA = (size_t)256 * DFF * 2; S.tstepB = (size_t)256 * DFF * 2; S.nt = DFF / 64;
            pg8::EpiBf16 E{(bf16_t*)(ws + WS_F_FFN), DM};
            pg8::gemm_phase<false, GSP2, GALIGN>(lds, DFF, DFF, S, E);
            GRID_BAR();
        }
        if (IN(3)) {
            LAUNDER();
            resnorm_rows((const bf16_t*)(ws + WS_F_FFN), XN, RSTD, nullptr, 0.5f, a.ffn1_norm + (size_t)(l * 2 + 1) * DM, gw, NGW, lane, ws + WS_XN8);
            GRID_BAR();
        }
        if (IN(4)) for (int rep_ = 0; rep_ < (((RPT_MASK >> 4) & 1) ? 2 : 1); ++rep_) {
            LAUNDER();
#ifndef NO_PROJ
            {
                pg8::SchedPlain S; S.o.init(M / 256, MIXIN / 256, G, bid, COLCH); S.A = (const char*)XN; S.B = (const char*)(ws + WS_WIN); S.tstepA = (size_t)256 * DM * 2; S.tstepB = (size_t)256 * DM * 2; S.nt = DM / 64;
                pg8::EpiBf16 E{(bf16_t*)(ws + WS_PROJ), MIXIN};
                pg8::gemm_phase<false, GSP2, GALIGN>(lds, DM, DM, S, E); }
#endif
#ifndef NO_G8
            {
                constexpr int NB8 = ((F8MASK >> 0) & 1) + ((F8MASK >> 1) & 1) + ((F8MASK >> 2) & 1) + ((F8MASK >> 3) & 1);
                if constexpr (NB8 > 0) {
                pg8::SchedPlain S; S.o.init(M / 256, 8 * NB8, G, bid, COLCH); S.A = (const char*)(ws + WS_XN8); S.B = (const char*)(ws + WS_WG8); S.tstepA = (size_t)256 * DM; S.tstepB = (size_t)256 * DM; S.nt = DM / 128; S.bmap = branch_list(F8MASK);
                pg8::EpiGates E{ws + WS_GATES, 1.0f / GATE_WSCALE};
                pg8::gemm_phase<true, GSP2, GALIGN>(lds, DM / 2, DM / 2, S, E); }
                if constexpr (NB8 < 4) {
                pg8::SchedPlain S; S.o.init(M / 256, 8 * (4 - NB8), G, bid, COLCH); S.A = (const char*)XN; S.B = (const char*)(ws + WS_WIN) + (size_t)MIXIN * DM * 2; S.tstepA = (size_t)256 * DM * 2; S.tstepB = (size_t)256 * DM * 2; S.nt = DM / 64; S.bmap = branch_list(~F8MASK & 15);
                pg8::EpiGates E{ws + WS_GATES, 1.0f};
                pg8::gemm_phase<false, GSP2, GALIGN>(lds, DM, DM, S, E); } }
#endif
            GRID_BAR();
        }
        if (IN(5)) for (int rep_ = 0; rep_ < (((RPT_MASK >> 5) & 1) ? 2 : 1); ++rep_) {
            LAUNDER();
            const bf16_t* proj = (const bf16_t*)(ws + WS_PROJ); bf16_t* yall = (bf16_t*)(ws + WS_YALL);
            { unsigned fq[16], vp[8];
#pragma unroll
              for (int r = 0; r < 16; ++r) { fq[r] = 0u; vp[r >> 1] = 0u; }
              for (int it = bid; it < 2048; it += G) { hgrn_a1_load(a, it, tid, fq, vp); hgrn_a1_item(lds, a, l, it, -1, fq, vp, tid, wave, lane); } }
            __syncthreads();
            for (int it = bid; it < 2048; it += G) { const int nb = 31 - (it & 31), h = (it >> 5) & 7, b = it >> 8; stickbreak_item(lds, MISC + 16, proj, yall, b, h, nb, tid, wave, lane); }
            __syncthreads();
            { WinRegs R; WinArgs W = win_args_c(a, proj, bid);
              win_fetch(W, tid, wave, lane, R);
              for (int it = bid; it < 3072; it += G) { const bool hn = it + G < 3072; const WinArgs Wn = win_args_c(a, proj, hn ? it + G : it);
                  attn_win_item(lds, W, R, hn, Wn, tid, wave, lane); W = Wn; } }
            __syncthreads();
            { WinRegs R; WinArgs W = win_args_d(a, proj, yall, l, bid);
              win_fetch(W, tid, wave, lane, R);
              for (int it = bid; it < 2048; it += G) { const bool hn = it + G < 2048; const WinArgs Wn = win_args_d(a, proj, yall, l, hn ? it + G : it);
                  attn_win_item(lds, W, R, hn, Wn, tid, wave, lane); W = Wn; } }
            GRID_BAR();
        }
        if (IN(6)) for (int rep_ = 0; rep_ < (((RPT_MASK >> 6) & 1) ? 2 : 1); ++rep_) {
            LAUNDER();
            hgrn_a2(a, gtid, gthreads);
            c_combine(a, gtid, gthreads);
            GRID_BAR();
        }
        if (IN(7)) for (int rep_ = 0; rep_ < (((RPT_MASK >> 7) & 1) ? 2 : 1); ++rep_) {
            LAUNDER();
            for (int it = bid; it < 2048; it += G) hgrn_a3_item(lds, a, l, it, tid, wave, lane);
            GRID_BAR();
        }
        if (IN(8)) for (int rep_ = 0; rep_ < (((RPT_MASK >> 8) & 1) ? 2 : 1); ++rep_) {
            LAUNDER();
            pg8::SchedBranch S; S.o.init(M / 256, DM / 256, G, bid); S.A = (const char*)(ws + WS_YALL); S.B = (const char*)(ws + WS_WBR); S.tstepA = (size_t)256 * BRT * 2; S.tstepB = (size_t)256 * BRT * 2;
            pg8::EpiBranch E{(bf16_t*)(ws + WS_MERGED), ws + WS_GATES};
            pg8::gemm_phase<false, GSP2, GALIGN>(lds, BRT, BRT, S, E);
            GRID_BAR();
        }
        if (IN(9)) for (int rep_ = 0; rep_ < (((RPT_MASK >> 9) & 1) ? 2 : 1); ++rep_) {
            LAUNDER();
            pg8::SchedPlain S; S.o.init(M / 256, DM / 256, G, bid); S.A = (const char*)(ws + WS_MERGED); S.B = (const char*)(ws + WS_WOUT); S.tstepA = (size_t)256 * DM * 2; S.tstepB = (size_t)256 * DM * 2; S.nt = DM / 64;
            pg8::EpiBf16 E{(bf16_t*)(ws + WS_F_MIX), DM};
            pg8::gemm_phase<false, GSP2, GALIGN>(lds, DM, DM, S, E);
            GRID_BAR();
        }
        if (IN(10)) {
            LAUNDER();
            resnorm_rows((const bf16_t*)(ws + WS_F_MIX), XN, RSTD, nullptr, 1.0f, a.mix_norm + (size_t)(l * 2 + 1) * DM, gw, NGW, lane);
            GRID_BAR();
        }
        if (IN(11)) for (int rep_ = 0; rep_ < (((RPT_MASK >> 11) & 1) ? 2 : 1); ++rep_) {
            LAUNDER();
            pg8::SchedPlain S; S.o.init(M / 256, 2 * DFF / 256, G, bid, COLCH); S.A = (const char*)XN; S.B = (const char*)(ws + WS_W13B); S.tstepA = (size_t)256 * DM * 2; S.tstepB = (size_t)256 * DM * 2; S.nt = DM / 64;
            pg8::EpiSwiglu E{(bf16_t*)(ws + WS_ACT), DFF};
            pg8::gemm_phase<false, GSP2, GALIGN>(lds, DM, DM, S, E);
            GRID_BAR();
        }
        if (IN(12)) for (int rep_ = 0; rep_ < (((RPT_MASK >> 12) & 1) ? 2 : 1); ++rep_) {
            LAUNDER();
            pg8::SchedPlain S; S.o.init(M / 256, DM / 256, G, bid, 1); S.A = (const char*)(ws + WS_ACT); S.B = (const char*)(ws + WS_W2B); S.tstepA = (size_t)256 * DFF * 2; S.tstepB = (size_t)256 * DFF * 2; S.nt = DFF / 64;
            pg8::EpiBf16 E{(bf16_t*)(ws + WS_F_FFN), DM};
            pg8::gemm_phase<false, GSP2, GALIGN>(lds, DFF, DFF, S, E);
            GRID_BAR();
        }
        if (IN(13)) {
            LAUNDER();
            const bool lastl = (l + 1 == DEPTH);
            resnorm_rows((const bf16_t*)(ws + WS_F_FFN), XN, RSTD, lastl ? a.out : nullptr, 0.5f, a.ffn2_norm + (size_t)(l * 2 + 1) * DM, gw, NGW, lane);
            if (!lastl) { __syncthreads(); convert_weights(a, l + 1, lds, bid, G, lane, wave); GRID_BAR(); }
        }
#undef IN
    }
}

extern "C" void kernel_launch(void* const* d_in, const int* in_sizes, int n_in, void* d_out, int out_size, void* d_ws, size_t ws_size, hipStream_t stream) {
    static int grid = 0;
    if (grid == 0) {
        if (n_in != 15 || in_sizes[0] != M * DM || out_size != M * DM || ws_size < WS_END) { fprintf(stderr, "kernel_launch: unexpected shapes (n_in %d, in0 %d, out %d, ws %zu < %zu)\n", n_in, n_in > 0 ? in_sizes[0] : -1, out_size, ws_size, (size_t)WS_END); grid = -1; return; }
        int dev = 0, cus = 0, per_cu = 0;
        if (hipGetDevice(&dev) != hipSuccess || hipDeviceGetAttribute(&cus, hipDeviceAttributeMultiprocessorCount, dev) != hipSuccess) { grid = -1; return; }
        if (hipFuncSetAttribute((const void*)fwd_kernel, hipFuncAttributeMaxDynamicSharedMemorySize, LDS_BYTES) != hipSuccess) { fprintf(stderr, "kernel_launch: hipFuncSetAttribute failed\n"); grid = -1; return; }
        if (hipOccupancyMaxActiveBlocksPerMultiprocessor(&per_cu, (const void*)fwd_kernel, 512, LDS_BYTES) != hipSuccess || per_cu < 1) fprintf(stderr, "kernel_launch: occupancy query reports %d\n", per_cu);
        (void)hipGetLastError();
        grid = cus;
    }
    if (grid < 0) return;
    if (hipMemsetAsync((char*)d_ws + WS_CTL, 0, 1 * MiB, stream) != hipSuccess) return;
    Args a{};
    a.x = (const float*)d_in[0]; a.ffn1_norm = (const float*)d_in[1]; a.ffn1_w13 = (const float*)d_in[2]; a.ffn1_w2 = (const float*)d_in[3]; a.mix_norm = (const float*)d_in[4]; a.w_in = (const float*)d_in[5];
    a.lb_logits = (const float*)d_in[6]; a.hgrn_norm = (const float*)d_in[7]; a.sinks = (const float*)d_in[8]; a.w_branch = (const float*)d_in[9]; a.w_out = (const float*)d_in[10];
    a.ffn2_norm = (const float*)d_in[11]; a.ffn2_w13 = (const float*)d_in[12]; a.ffn2_w2 = (const float*)d_in[13]; a.rel_bias = (const float*)d_in[14];
    a.out = (float*)d_out; a.ws = (unsigned char*)d_ws;
#if MK_ONE_LAUNCH
    a.l_lo = 0; a.l_hi = DEPTH; a.ph_lo = 0; a.ph_hi = NPH;
    hipLaunchKernelGGL(fwd_kernel, dim3(grid), dim3(512), LDS_BYTES, stream, a);
#else
    for (int l = 0; l < DEPTH; ++l)
        for (int p = (l == 0 ? 0 : 1); p < NPH; ++p) { a.l_lo = l; a.l_hi = l + 1; a.ph_lo = p; a.ph_hi = p + 1; hipLaunchKernelGGL(fwd_kernel, dim3(grid), dim3(512), LDS_BYTES, stream, a); }
#endif
}
```
